# Optimizing an MI355X kernel written in HIP

```python
import math
import jax, jax.numpy as jnp
from jax import lax
import numpy as np

D_MODEL = 2048
BATCH = 4
SEQ = 4096
DEPTH = 1

POOL_WIDTH = D_MODEL // 2
POOL_GROUPS = 4
POOL_WINDOWS = (2, 4, 8, 16)
POOL_GROUP_DIM = POOL_WIDTH // POOL_GROUPS
GLA_V_WIDTH = D_MODEL - POOL_WIDTH
GLA_HEADS = 4
GLA_HEAD_V = GLA_V_WIDTH // GLA_HEADS
GLA_K_WIDTH = GLA_V_WIDTH // 2
GLA_HEAD_K = GLA_K_WIDTH // GLA_HEADS
GLA_GATE_RANK = 16
GLA_GATE_TAU = 16.0
GLA_CHUNK = 64
GLA_NORM_EPS = 1e-6
SPLITS = (POOL_WIDTH,
          POOL_WIDTH + GLA_K_WIDTH,
          POOL_WIDTH + 2 * GLA_K_WIDTH,
          POOL_WIDTH + 2 * GLA_K_WIDTH + GLA_V_WIDTH,
          POOL_WIDTH + 2 * GLA_K_WIDTH + GLA_V_WIDTH + GLA_GATE_RANK)
IN_WIDTH = SPLITS[-1] + GLA_V_WIDTH
N_EXPERTS = 32
TOP_K = 4
D_FF = D_MODEL
SWIGLU_ALPHA = 1.702
SWIGLU_LIMIT = 7.0
MOE_BLOCK = 128
DEEPNORM_ALPHA = (2.0 * DEPTH) ** 0.25
DEEPNORM_BETA = (8.0 * DEPTH) ** -0.25
LN_EPS = 1e-5

kernel_name = "hymba_pool_gla_moe_adaln_deepnorm"


def _layer_norm(x):
    xf = x.astype(jnp.float32)
    mu = jnp.mean(xf, axis=-1, keepdims=True)
    var = jnp.mean(jnp.square(xf - mu), axis=-1, keepdims=True)
    return (xf - mu) * lax.rsqrt(var + LN_EPS)


def _post_ln(y, g, b, dtype):
    return (_layer_norm(y) * g + b).astype(dtype)


def _modulate(x, shift, scale):
    return (_layer_norm(x) * (1.0 + scale) + shift).astype(x.dtype)


def _pool_mixer(u, w_pool, b_pool, pool_scale):
    bsz, s, _ = u.shape
    uf = u.astype(jnp.float32).reshape(bsz, s, POOL_GROUPS, POOL_GROUP_DIM)
    cs = jnp.cumsum(uf, axis=1)
    pos = jnp.arange(1, s + 1)
    outs = []
    for g, w in enumerate(POOL_WINDOWS):
        csg = cs[:, :, g]
        lagged = jnp.pad(csg[:, : s - w], ((0, 0), (w, 0), (0, 0)))
        count = jnp.minimum(pos, w).astype(jnp.float32)[None, :, None]
        outs.append((csg - lagged) / count - uf[:, :, g])
    pooled = jnp.stack(outs, axis=2)
    mixed = jnp.einsum('bsgc,gcd->bsgd', pooled, w_pool.astype(jnp.float32))
    mixed = mixed.reshape(bsz, s, POOL_WIDTH) + b_pool
    return (mixed * pool_scale).astype(u.dtype)


def _gla_mixer(q, k, v, gk_lowrank, g, w_gk, b_gk, norm_w):
    bsz, s, _ = q.shape
    n_chunks = s // GLA_CHUNK
    f32 = jnp.float32

    def to_chunks(a, dh):
        a = a.astype(f32).reshape(bsz, n_chunks, GLA_CHUNK, GLA_HEADS, dh)
        return a.transpose(1, 0, 3, 2, 4)

    log_alpha = jax.nn.log_sigmoid(gk_lowrank.astype(f32) @ w_gk.astype(f32) + b_gk) / GLA_GATE_TAU
    qc = to_chunks(q, GLA_HEAD_K) * (GLA_HEAD_K ** -0.5)
    kc = to_chunks(k, GLA_HEAD_K)
    vc = to_chunks(v, GLA_HEAD_V)
    ac = to_chunks(log_alpha, GLA_HEAD_K)
    causal = jnp.tril(jnp.ones((GLA_CHUNK, GLA_CHUNK), dtype=bool))[None, None, :, :, None]

    def chunk_step(state, inp):
        qb, kb, vb, ab = inp
        bcum = jnp.cumsum(ab, axis=2)
        blast = bcum[:, :, -1:, :]
        o_inter = jnp.einsum('bhtd,bhdv->bhtv', qb * jnp.exp(bcum), state)
        rel = jnp.where(causal, bcum[:, :, :, None, :] - bcum[:, :, None, :, :], -jnp.inf)
        scores = jnp.einsum('bhtd,bhsd,bhtsd->bhts', qb, kb, jnp.exp(rel))
        o_intra = jnp.einsum('bhts,bhsv->bhtv', scores, vb)
        new_state = jnp.exp(blast[:, :, 0, :])[..., None] * state + jnp.einsum(
            'bhsd,bhsv->bhdv', kb * jnp.exp(blast - bcum), vb)
        return new_state, o_inter + o_intra

    state0 = jnp.zeros((bsz, GLA_HEADS, GLA_HEAD_K, GLA_HEAD_V), f32)
    _, o = lax.scan(chunk_step, state0, (qc, kc, vc, ac))
    o = o.transpose(1, 0, 3, 2, 4).reshape(bsz, s, GLA_HEADS, GLA_HEAD_V)
    o = o * lax.rsqrt(jnp.mean(o * o, axis=-1, keepdims=True) + GLA_NORM_EPS) * norm_w
    gate = jax.nn.silu(g.astype(f32)).reshape(bsz, s, GLA_HEADS, GLA_HEAD_V)
    return (o * gate).reshape(bsz, s, GLA_V_WIDTH).astype(q.dtype)


def _mixer(h, w_in, w_gk, b_gk, w_pool, b_pool, pool_scale, gla_norm_w, w_out):
    proj = h @ w_in
    u, q, k, v, gk_lr, g = jnp.split(proj, list(SPLITS), axis=-1)
    y_pool = _pool_mixer(u, w_pool, b_pool, pool_scale)
    y_gla = _gla_mixer(q, k, v, gk_lr, g, w_gk, b_gk, gla_norm_w)
    return jnp.concatenate([y_pool, y_gla], axis=-1) @ w_out


def _moe(h, w_router, b_router, w_gate, b_gate, w_up, b_up, w_down, b_down):
    bsz, s, d = h.shape
    n_tok = bsz * s
    xf = h.reshape(n_tok, d)
    logits = (xf @ w_router + b_router).astype(jnp.float32)
    top_vals, top_idx = lax.top_k(logits, TOP_K)
    top_w = jax.nn.softmax(top_vals, axis=-1)
    n_assign = n_tok * TOP_K
    flat_e = top_idx.reshape(-1)
    flat_tok = jnp.repeat(jnp.arange(n_tok, dtype=jnp.int32), TOP_K)
    flat_w = top_w.reshape(-1)
    order = jnp.argsort(flat_e)
    sorted_e = flat_e[order]
    sorted_tok = flat_tok[order]
    sorted_w = flat_w[order]
    counts = jnp.bincount(flat_e, length=N_EXPERTS)
    padded = (counts + MOE_BLOCK - 1) // MOE_BLOCK * MOE_BLOCK
    group_start = jnp.cumsum(counts) - counts
    pad_end = jnp.cumsum(padded)
    pad_start = pad_end - padded
    rank = jnp.arange(n_assign, dtype=jnp.int32) - group_start[sorted_e]
    dest = pad_start[sorted_e] + rank
    n_slots = (n_assign + MOE_BLOCK - 1) // MOE_BLOCK * MOE_BLOCK + N_EXPERTS * MOE_BLOCK
    n_blocks = n_slots // MOE_BLOCK
    slot_tok = jnp.zeros((n_slots,), jnp.int32).at[dest].set(sorted_tok)
    slot_w = jnp.zeros((n_slots,), jnp.float32).at[dest].set(sorted_w)
    block_e = jnp.minimum(
        jnp.searchsorted(pad_end, jnp.arange(n_blocks) * MOE_BLOCK, side='right'), N_EXPERTS - 1)

    def expert_block(args):
        tok, e = args
        xb = xf[tok]
        gate = jnp.minimum(xb @ w_gate[e] + b_gate[e], SWIGLU_LIMIT)
        up = jnp.clip(xb @ w_up[e] + b_up[e], -SWIGLU_LIMIT, SWIGLU_LIMIT)
        act = gate * jax.nn.sigmoid(SWIGLU_ALPHA * gate) * (up + 1.0)
        return act @ w_down[e] + b_down[e]

    y = lax.map(expert_block, (slot_tok.reshape(n_blocks, MOE_BLOCK), block_e))
    y = y.reshape(n_slots, d) * slot_w[:, None].astype(y.dtype)
    out = jnp.zeros((n_tok, d), y.dtype).at[slot_tok].add(y)
    return out.reshape(bsz, s, d)


def setup_inputs(seed: int = 0) -> dict:
    key = jax.random.key(seed)
    ks = jax.random.split(key, 24)
    L, D, E, F = DEPTH, D_MODEL, N_EXPERTS, D_FF

    def nrm(k, shape, scale):
        return jax.random.normal(k, shape, jnp.float32) * scale

    col_scale = jnp.concatenate([
        jnp.ones((SPLITS[2],), jnp.float32),
        jnp.full((GLA_V_WIDTH,), DEEPNORM_BETA, jnp.float32),
        jnp.ones((IN_WIDTH - SPLITS[3],), jnp.float32)])
    return {
        "x": nrm(ks[0], (BATCH, SEQ, D), 1.0),
        "c": nrm(ks[1], (BATCH, D), 1.0),
        "w_ada": nrm(ks[2], (L, D, 6 * D), 0.5 * D ** -0.5),
        "b_ada": nrm(ks[3], (L, 6 * D), 0.02),
        "w_in": nrm(ks[4], (L, D, IN_WIDTH), D ** -0.5) * col_scale,
        "w_gk": nrm(ks[5], (L, GLA_GATE_RANK, GLA_K_WIDTH), GLA_GATE_RANK ** -0.5),
        "b_gk": nrm(ks[6], (L, GLA_K_WIDTH), 0.1),
        "w_pool": nrm(ks[7], (L, POOL_GROUPS, POOL_GROUP_DIM, POOL_GROUP_DIM), POOL_GROUP_DIM ** -0.5),
        "b_pool": nrm(ks[8], (L, POOL_WIDTH), 0.02),
        "pool_scale": 1.0 + nrm(ks[9], (L, POOL_WIDTH), 0.05),
        "gla_norm_w": 1.0 + nrm(ks[10], (L, GLA_HEAD_V), 0.05),
        "w_out": nrm(ks[11], (L, D, D), DEEPNORM_BETA * D ** -0.5),
        "ln1_g": 1.0 + nrm(ks[12], (L, D), 0.05),
        "ln1_b": nrm(ks[13], (L, D), 0.02),
        "w_router": nrm(ks[14], (L, D, E), D ** -0.5),
        "b_router": nrm(ks[15], (L, E), 0.01),
        "w_gate": nrm(ks[16], (L, E, D, F), D ** -0.5),
        "b_gate": nrm(ks[17], (L, E, F), 0.02),
        "w_up": nrm(ks[18], (L, E, D, F), D ** -0.5),
        "b_up": nrm(ks[19], (L, E, F), 0.02),
        "w_down": nrm(ks[20], (L, E, F, D), DEEPNORM_BETA * F ** -0.5),
        "b_down": nrm(ks[21], (L, E, D), 0.02),
        "ln2_g": 1.0 + nrm(ks[22], (L, D), 0.05),
        "ln2_b": nrm(ks[23], (L, D), 0.02),
    }


def reference(x, c, w_ada, b_ada, w_in, w_gk, b_gk, w_pool, b_pool, pool_scale, gla_norm_w, w_out,
              ln1_g, ln1_b, w_router, b_router, w_gate, b_gate, w_up, b_up, w_down, b_down,
              ln2_g, ln2_b):
    for l in range(DEPTH):
        mod = jax.nn.silu(c) @ w_ada[l] + b_ada[l]
        sh1, sc1, g1, sh2, sc2, g2 = jnp.split(mod[:, None, :], 6, axis=-1)
        h = _modulate(x, sh1, sc1)
        y = _mixer(h, w_in[l], w_gk[l], b_gk[l], w_pool[l], b_pool[l], pool_scale[l],
                   gla_norm_w[l], w_out[l])
        x = _post_ln(DEEPNORM_ALPHA * x + g1 * y, ln1_g[l], ln1_b[l], x.dtype)
        h = _modulate(x, sh2, sc2)
        y = _moe(h, w_router[l], b_router[l], w_gate[l], b_gate[l], w_up[l], b_up[l],
                 w_down[l], b_down[l])
        x = _post_ln(DEEPNORM_ALPHA * x + g2 * y, ln2_g[l], ln2_b[l], x.dtype)
    return x
```

```cpp
#include <hip/hip_runtime.h>
#include <cstdio>
#include <cstdint>

#ifndef MK_N_LAUNCHES
#define MK_N_LAUNCHES 1
#endif

#ifndef PROBE_SUB
#define PROBE_SUB 0
#endif
#define GAS __attribute__((address_space(1)))
#define LAS __attribute__((address_space(3)))
typedef unsigned short bf16;
typedef unsigned v4u __attribute__((ext_vector_type(4)));
typedef unsigned v2u __attribute__((ext_vector_type(2)));
typedef float f32x4 __attribute__((ext_vector_type(4)));
typedef float f32x2 __attribute__((ext_vector_type(2)));
typedef short bf16x8 __attribute__((ext_vector_type(8)));
typedef int i32x8 __attribute__((ext_vector_type(8)));
typedef GAS unsigned gu32;
#define RLX_AGENT __ATOMIC_RELAXED, __HIP_MEMORY_SCOPE_AGENT
#define LDS_WAIT() asm volatile("s_waitcnt lgkmcnt(0)" ::: "memory")
#define VM_WAIT() asm volatile("s_waitcnt vmcnt(0)" ::: "memory")

constexpr int NB = 4, SEQ = 4096, D = 2048, T = NB * SEQ;
constexpr int INW = 4112;
constexpr int NPROJ = 4096;
constexpr int C_U = 0, C_Q = 1024, C_K = 1536, C_V = 2048, C_G = 3072;
constexpr int NE = 32, ECAP = 16384;
constexpr int NSLOT = 65536 + NE * 256;
constexpr float LN_EPS = 1e-5f, ALPHA = 1.189207115002721f;
constexpr int NWAVES = 8;
constexpr int NPH = 11;
constexpr int NCONV8 = 3;

constexpr size_t MiB = 1u << 20;
constexpr size_t WS_CTL = 0, WS_STOK = 1 * MiB, ZERO_BYTES = 3 * MiB;
constexpr size_t WS_MOD = 3 * MiB, WS_GK = 4 * MiB, WS_TOPE = 5 * MiB, WS_TOPW = WS_TOPE + 256 * 1024, WS_RANK = WS_TOPW + 256 * 1024;
constexpr size_t WS_WRT = WS_RANK + 256 * 1024;
constexpr size_t WS_DEC = 6 * MiB, WS_WPOOL = 7 * MiB, WS_WOUT = 8 * MiB, WS_WIN = 16 * MiB, WS_WGU = 32 * MiB, WS_WDN = 544 * MiB;
constexpr size_t WS_X1 = 800 * MiB, WS_H = 928 * MiB, WS_PROJ = 992 * MiB, WS_MIX = 1120 * MiB, WS_SLOC = 1184 * MiB, WS_ST = 1312 * MiB, WS_Z = 1376 * MiB;
constexpr size_t WS_KHT = WS_SLOC, WS_VT = WS_SLOC + 16 * MiB, WS_QKH = WS_SLOC + 48 * MiB, WS_VT5 = WS_SLOC + 80 * MiB;
constexpr size_t WS_ACT = 992 * MiB;
constexpr size_t WS_Y = 1504 * MiB, WS_END = 1792 * MiB;
static_assert(WS_ACT + (size_t)NSLOT * D <= WS_ST && WS_Y + (size_t)NSLOT * D * 2 <= WS_END, "ws map");
constexpr int CW_TMO = 0;
constexpr int CW_CNT = 1024;
constexpr int CW_Q0 = 3072;
constexpr int CW_BAR = 4096;

constexpr int RING_BYTES = 131072;
constexpr int LDS_BYTES = 163840;
constexpr int LDSCTL_OFF = LDS_BYTES - 2048, TS_OFF = LDSCTL_OFF + 512, MISC_OFF = LDSCTL_OFF + 1024;

__device__ __forceinline__ unsigned f2bf(float f) { unsigned u = __builtin_bit_cast(unsigned, f); return (u + 0x7fffu + ((u >> 16) & 1u)) >> 16; }
__device__ __forceinline__ unsigned pk2(float lo, float hi) { return f2bf(lo) | (f2bf(hi) << 16); }
__device__ __forceinline__ float bflo(unsigned w) { return __builtin_bit_cast(float, w << 16); }
__device__ __forceinline__ float bfhi(unsigned w) { return __builtin_bit_cast(float, w & 0xffff0000u); }
__device__ __forceinline__ float bf2f(bf16 b) { return __builtin_bit_cast(float, ((unsigned)b) << 16); }
template <int CTRL> __device__ __forceinline__ float dpp_mov(float v) { return __builtin_bit_cast(float, __builtin_amdgcn_update_dpp(0, __builtin_bit_cast(int, v), CTRL, 0xf, 0xf, true)); }
__device__ __forceinline__ float rdlane(float v, int l) { return __builtin_bit_cast(float, __builtin_amdgcn_readlane(__builtin_bit_cast(int, v), l)); }
__device__ __forceinline__ float wave_sum(float v) {
    v += dpp_mov<0xB1>(v); v += dpp_mov<0x4E>(v); v += dpp_mov<0x141>(v); v += dpp_mov<0x140>(v);
    return (rdlane(v, 0) + rdlane(v, 16)) + (rdlane(v, 32) + rdlane(v, 48));
}
__device__ __forceinline__ unsigned pk4_fp8(float a, float b, float c, float d) { int w = 0; w = __builtin_amdgcn_cvt_pk_fp8_f32(a, b, w, false); w = __builtin_amdgcn_cvt_pk_fp8_f32(c, d, w, true); return (unsigned)w; }
constexpr float W8_SCALE = 64.0f, ACT8_SCALE = 4.0f;
template <class V> __device__ __forceinline__ V ldg(const void* ubase, unsigned off) { return *(const V*)((const char*)ubase + off); }
template <class V> __device__ __forceinline__ void stg(void* ubase, unsigned off, V v) { *(V*)((char*)ubase + off) = v; }
__device__ __forceinline__ f32x4 mma16(bf16x8 a, bf16x8 b, f32x4 c) { return __builtin_amdgcn_mfma_f32_16x16x32_bf16(a, b, c, 0, 0, 0); }

#ifndef KROT
#define KROT 1
#endif
namespace pg8 {
#define PG8_LAS __attribute__((address_space(3)))
typedef unsigned short bf16_t;
typedef unsigned u32x4 __attribute__((ext_vector_type(4)));
typedef int i32x4_t __attribute__((ext_vector_type(4)));
constexpr int BM = 256, BK = 64, HALF = 128, HTB = HALF * BK * 2, STAGE_BYTES = 8 * HTB, NXCD = 8, WGM = 8;

__host__ __device__ __forceinline__ int lds_byte(int r, int c) { const int st = (r >> 4) * 2 + (c >> 5), rr = r & 15, cc = c & 31, ob = rr * 64 + cc * 2; return st * 1024 + (ob ^ (((ob >> 9) & 1) << 5)); }
__host__ __device__ __forceinline__ void stage_rc(int b, int& R, int& C) { const int st = b / 1024, sb = b % 1024, swz = sb ^ (((sb >> 9) & 1) << 5); R = (st >> 1) * 16 + swz / 64; C = (st & 1) * 32 + (swz % 64) / 2; }
__host__ __device__ __forceinline__ int perm32(int rho) { const int n = rho >> 4, i = rho & 15; return 8 * (i >> 2) + 4 * n + (i & 3); }

struct Unit { int pm, pn, e, gm; };
struct Gemm { const bf16_t* A; const bf16_t* Bt; int K; size_t bstride; const int* rowidx; };

struct DenseOrder {
    int nM, nN, nwg, G, c;
    __device__ void init(int M, int N, int G_, int c_) { nM = M / BM; nN = N / BM; nwg = nM * nN; G = G_; c = c_; }
    __device__ __forceinline__ bool next(int i, Unit& u, int) const {
        const long L = (long)i * G + c; if (L >= nwg) return false;
        int wgid = (int)L; { const int q = nwg / NXCD, r = nwg % NXCD, xcd = wgid % NXCD, off = wgid / NXCD; wgid = (xcd < r ? xcd * (q + 1) : r * (q + 1) + (xcd - r) * q) + off; }
        const int nig = WGM * nN, gid = wgid / nig, fm = gid * WGM, gsz = (nM - fm) < WGM ? (nM - fm) : WGM;
        u.pm = fm + ((wgid % nig) % gsz); u.pn = (wgid % nig) / gsz; u.e = 0; u.gm = 0; return true;
    }
};
struct GroupOrder {
    const PG8_LAS int* ts; int nN, G, c, total, xr;
    __device__ void init(const PG8_LAS int* ts_, int nN_, int G_, int c_, int xr_ = 0) { ts = ts_; nN = nN_; G = G_; c = c_; xr = xr_; total = __builtin_amdgcn_readfirstlane(ts_[32]) * nN_; }
    __device__ __forceinline__ bool next(int i, Unit& u, int e0) const {
        int mt;
        if (xr) { const int k = c >> 3; mt = 4 * (i * 8 + (c & 7)) + (k >> 3); u.pn = k & 7; if (mt * nN >= total) return false; }
        else { const long L = (long)i * G + c; if (L >= total) return false; mt = (int)(L / nN); u.pn = (int)(L % nN); }
        int e = e0;
#pragma unroll 1
        while (e < 31 && ts[e + 1] <= mt) ++e;
        e = __builtin_amdgcn_readfirstlane(e); const int t0 = __builtin_amdgcn_readfirstlane(ts[e]);
        u.pm = mt; u.e = e; u.gm = e * (ECAP / 256) + (mt - t0); return true;
    }
};

__device__ __forceinline__ unsigned cvt_pk_bf16(float lo, float hi) { unsigned r; asm volatile("v_cvt_pk_bf16_f32 %0, %1, %2" : "=v"(r) : "v"(lo), "v"(hi)); return r; }

struct EpiBf16 {
    static constexpr bool PERM = true;
    bf16_t* O; int ldc; const float* bias; int bstride; float ascale; bool nt;
    __device__ __forceinline__ void operator()(const f32x4 (&acc)[2][2][4][2], const Unit& u, int wr, int wc, int fr, int fq) const {
        const int row0 = u.pm * BM + wr * 64 + fr; const int col0 = u.pn * BM + wc * 32 + 8 * fq;
        f32x4 bv[2][2];
#pragma unroll
        for (int bj = 0; bj < 2; ++bj)
#pragma unroll
            for (int n = 0; n < 2; ++n) bv[bj][n] = bias ? *(const f32x4*)(bias + (size_t)u.e * bstride + col0 + bj * HALF + 4 * n) : (f32x4){0.f, 0.f, 0.f, 0.f};
#pragma unroll
        for (int ai = 0; ai < 2; ++ai)
#pragma unroll
            for (int m = 0; m < 4; ++m) { bf16_t* rowp = O + (size_t)(row0 + ai * HALF + m * 16) * ldc + col0;
#pragma unroll
                for (int bj = 0; bj < 2; ++bj) { const f32x4 v0 = acc[ai][bj][m][0] * ascale + bv[bj][0], v1 = acc[ai][bj][m][1] * ascale + bv[bj][1];
                    u32x4 w; w.x = cvt_pk_bf16(v0[0], v0[1]); w.y = cvt_pk_bf16(v0[2], v0[3]); w.z = cvt_pk_bf16(v1[0], v1[1]); w.w = cvt_pk_bf16(v1[2], v1[3]);
                    if (nt) __builtin_nontemporal_store(w, (u32x4*)(rowp + bj * HALF)); else *(u32x4*)(rowp + bj * HALF) = w; } }
    }
};
__device__ __forceinline__ float swiglu1(float g, float u) {
    g = fminf(g, 7.0f); u = __builtin_amdgcn_fmed3f(u, -7.0f, 7.0f);
    const float e = __builtin_amdgcn_exp2f(g * -2.4554669595930157f);
    const float gs = g * __builtin_amdgcn_rcpf(e * (1.0f / ACT8_SCALE) + (1.0f / ACT8_SCALE));
    return gs * u + gs;
}
struct EpiSwiglu {
    static constexpr bool PERM = true;
    unsigned char* O; const float* bg; const float* bu;
    __device__ __forceinline__ void operator()(const f32x4 (&acc)[2][2][4][2], const Unit& u, int wr, int wc, int fr, int fq) const {
        const int row0 = u.pm * BM + wr * 64 + fr; const int col0 = u.pn * HALF + wc * 32 + 8 * fq; constexpr float is = 1.0f / W8_SCALE;
        f32x4 gv[2], uv[2];
#pragma unroll
        for (int n = 0; n < 2; ++n) { gv[n] = *(const f32x4*)(bg + (size_t)u.e * 2048 + col0 + 4 * n); uv[n] = *(const f32x4*)(bu + (size_t)u.e * 2048 + col0 + 4 * n); }
#pragma unroll
        for (int ai = 0; ai < 2; ++ai)
#pragma unroll
            for (int m = 0; m < 4; ++m) { unsigned char* rowp = O + (size_t)(row0 + ai * HALF + m * 16) * 2048 + col0;
                const f32x4 g0 = acc[ai][0][m][0] * is + gv[0], g1 = acc[ai][0][m][1] * is + gv[1], u0 = acc[ai][1][m][0] * is + uv[0], u1 = acc[ai][1][m][1] * is + uv[1];
                v2u w; w.x = pk4_fp8(swiglu1(g0[0], u0[0]), swiglu1(g0[1], u0[1]), swiglu1(g0[2], u0[2]), swiglu1(g0[3], u0[3]));
                w.y = pk4_fp8(swiglu1(g1[0], u1[0]), swiglu1(g1[1], u1[1]), swiglu1(g1[2], u1[2]), swiglu1(g1[3], u1[3]));
                __builtin_nontemporal_store(w, (v2u*)rowp); }
    }
};
struct EpiG1 {
    static constexpr bool PERM = true;
    bf16_t* O; const float* mod;
    __device__ __forceinline__ void operator()(const f32x4 (&acc)[2][2][4][2], const Unit& u, int wr, int wc, int fr, int fq) const {
        const int row0 = u.pm * BM + wr * 64 + fr, col0 = u.pn * BM + wc * 32 + 8 * fq; const int b = u.pm >> 4;
        f32x4 gv[2][2];
#pragma unroll
        for (int bj = 0; bj < 2; ++bj)
#pragma unroll
            for (int n = 0; n < 2; ++n) gv[bj][n] = *(const f32x4*)(mod + (size_t)b * 12288 + 4096 + col0 + bj * HALF + 4 * n);
#pragma unroll
        for (int ai = 0; ai < 2; ++ai)
#pragma unroll
            for (int m = 0; m < 4; ++m) { bf16_t* rowp = O + (size_t)(row0 + ai * HALF + m * 16) * 2048 + col0;
#pragma unroll
                for (int bj = 0; bj < 2; ++bj) { const f32x4 v0 = acc[ai][bj][m][0] * gv[bj][0], v1 = acc[ai][bj][m][1] * gv[bj][1];
                    u32x4 w; w.x = cvt_pk_bf16(v0[0], v0[1]); w.y = cvt_pk_bf16(v0[2], v0[3]); w.z = cvt_pk_bf16(v1[0], v1[1]); w.w = cvt_pk_bf16(v1[2], v1[3]);
                    *(u32x4*)(rowp + bj * HALF) = w; } }
    }
};
template <class Epi, class Sched, bool GATHER, bool FP8>
__device__ __forceinline__ void gemm_phase(PG8_LAS unsigned char* lds, const Gemm g, const Sched& S, const Epi& E) {
    const int tid = threadIdx.x, wid = __builtin_amdgcn_readfirstlane(tid >> 6), lane = tid & 63, wr = wid >> 2, wc = wid & 3, fr = lane & 15, fq = lane >> 4;
    const unsigned PITCH = FP8 ? (unsigned)g.K : 2u * (unsigned)g.K;
    const int nt = (int)(PITCH / 128u);
    const unsigned rot = KROT ? ((unsigned)blockIdx.x & 7u) * (unsigned)(nt >> 3) : 0u, ntm = (unsigned)(nt - 1);
#define PG8_KO(x) ((((unsigned)(x)) + rot & ntm) * kstep)
    int R0, C0, R1, C1; stage_rc(tid * 16, R0, C0); stage_rc(tid * 16 + 8192, R1, C1);
    const unsigned CB0 = 2u * (unsigned)C0, CB1 = 2u * (unsigned)C1;
    unsigned voffB0, voffB1;
    { const int Rb0 = Epi::PERM ? ((R0 & ~31) + perm32(R0 & 31)) : R0, Rb1 = Epi::PERM ? ((R1 & ~31) + perm32(R1 & 31)) : R1;
      voffB0 = (unsigned)Rb0 * PITCH + CB0; voffB1 = (unsigned)Rb1 * PITCH + CB1; }
    const unsigned kstep = 128u, hstep = (unsigned)HALF * PITCH, tstep = 2u * hstep;
    const unsigned ldsw = (unsigned)wid * 1024u;
    const int aoff = FP8 ? lds_byte(wr * 64 + fr, fq * 16) + 16 * (fq & 1) : lds_byte(wr * 64 + fr, fq * 8), boff = FP8 ? lds_byte(wc * 32 + fr, fq * 16) + 16 * (fq & 1) : lds_byte(wc * 32 + fr, fq * 8);
    const int aoffx = aoff ^ 16, boffx = boff ^ 16;
    const __amdgpu_buffer_rsrc_t srdA = __builtin_amdgcn_make_buffer_rsrc((void*)g.A, 0, 0x7fffffff, 0x00020000);
    const __amdgpu_buffer_rsrc_t srdB = __builtin_amdgcn_make_buffer_rsrc((void*)g.Bt, 0, 0x7fffffff, 0x00020000);
#define PG8_SA(b, h) (((b) * 2 + (h)) * HTB)
#define PG8_SB(b, h) ((4 + (b) * 2 + (h)) * HTB)
#define PG8_STAGEB(bufoff, so) do { \
        __builtin_amdgcn_raw_ptr_buffer_load_lds(srdB, (PG8_LAS unsigned*)(lds + (bufoff) + ldsw), 16, (int)voffB0, (int)(so), 0, 0); \
        __builtin_amdgcn_raw_ptr_buffer_load_lds(srdB, (PG8_LAS unsigned*)(lds + (bufoff) + ldsw + 8192), 16, (int)voffB1, (int)(so), 0, 0); } while (0)
#define PG8_STAGEA(bufoff, so, o0, o1) do { \
        __builtin_amdgcn_raw_ptr_buffer_load_lds(srdA, (PG8_LAS unsigned*)(lds + (bufoff) + ldsw), 16, (int)(o0), (int)(so), 0, 0); \
        __builtin_amdgcn_raw_ptr_buffer_load_lds(srdA, (PG8_LAS unsigned*)(lds + (bufoff) + ldsw + 8192), 16, (int)(o1), (int)(so), 0, 0); } while (0)
#define PG8_LDA(dst, b, h) do { _Pragma("unroll") for (int m = 0; m < 4; ++m) _Pragma("unroll") for (int k = 0; k < 2; ++k) dst[m][k] = *(const PG8_LAS bf16x8*)(lds + PG8_SA(b, h) + (FP8 ? (k ? aoffx : aoff) + m * 2048 : aoff + m * 2048 + k * 1024)); } while (0)
#define PG8_LDB(dst, b, h) do { _Pragma("unroll") for (int n = 0; n < 2; ++n) _Pragma("unroll") for (int k = 0; k < 2; ++k) dst[n][k] = *(const PG8_LAS bf16x8*)(lds + PG8_SB(b, h) + (FP8 ? (k ? boffx : boff) + n * 2048 : boff + n * 2048 + k * 1024)); } while (0)
#define PG8_CAT(x) __builtin_shufflevector(__builtin_bit_cast(i32x4_t, x[0]), __builtin_bit_cast(i32x4_t, x[1]), 0, 1, 2, 3, 4, 5, 6, 7)
#define PG8_MMA(ai, bj, At, Bt) do { __builtin_amdgcn_s_setprio(1); \
        if constexpr (FP8) { _Pragma("unroll") for (int m = 0; m < 4; ++m) _Pragma("unroll") for (int n = 0; n < 2; ++n) \
            asm volatile("s_nop 1\n\tv_mfma_f32_16x16x128_f8f6f4 %0, %1, %2, %0" : "+v"(acc[ai][bj][m][n]) : "v"(PG8_CAT(Bt[n])), "v"(PG8_CAT(At[m]))); } \
        else { _Pragma("unroll") for (int m = 0; m < 4; ++m) _Pragma("unroll") for (int n = 0; n < 2; ++n) _Pragma("unroll") for (int k = 0; k < 2; ++k) \
            acc[ai][bj][m][n] = __builtin_amdgcn_mfma_f32_16x16x32_bf16(Bt[n][k], At[m][k], acc[ai][bj][m][n], 0, 0, 0); } \
        __builtin_amdgcn_s_setprio(0); } while (0)
#define PG8_WAIT_V(n) asm volatile("s_waitcnt vmcnt(" #n ")" ::: "memory")
#define PG8_WAIT_L(n) asm volatile("s_waitcnt lgkmcnt(" #n ")" ::: "memory")
#define PG8_BAR __builtin_amdgcn_s_barrier()
#define PG8_SCHED __builtin_amdgcn_sched_barrier(0)
#define PG8_ROWOFF(u, o00, o01, o10, o11) do { \
        if constexpr (GATHER) { const int* rp_ = g.rowidx + (size_t)(u).gm * BM; \
            o00 = (unsigned)rp_[R0] * PITCH + CB0; o01 = (unsigned)rp_[R1] * PITCH + CB1; \
            o10 = (unsigned)rp_[HALF + R0] * PITCH + CB0; o11 = (unsigned)rp_[HALF + R1] * PITCH + CB1; } \
        else { const unsigned rb_ = (unsigned)(u).pm * BM; \
            o00 = (rb_ + R0) * PITCH + CB0; o01 = (rb_ + R1) * PITCH + CB1; \
            o10 = (rb_ + HALF + R0) * PITCH + CB0; o11 = (rb_ + HALF + R1) * PITCH + CB1; } } while (0)
    Unit cur, nxt; int ui = 0;
    if (!S.next(0, cur, 0)) return;
    f32x4 acc[2][2][4][2];
#pragma unroll
    for (int a = 0; a < 2; ++a)
#pragma unroll
        for (int b = 0; b < 2; ++b)
#pragma unroll
            for (int m = 0; m < 4; ++m)
#pragma unroll
                for (int n = 0; n < 2; ++n) acc[a][b][m][n] = (f32x4){0.f, 0.f, 0.f, 0.f};
    bf16x8 At[4][2], B0[2][2], B1[2][2];
    unsigned c00, c01, c10, c11, n00, n01, n10, n11;
    PG8_ROWOFF(cur, c00, c01, c10, c11);
    n00 = c00; n01 = c01; n10 = c10; n11 = c11;
    unsigned cB = (unsigned)cur.e * (unsigned)g.bstride + (unsigned)cur.pn * tstep;
    PG8_STAGEB(PG8_SB(0, 0), cB + PG8_KO(0)); PG8_STAGEB(PG8_SB(0, 1), cB + hstep + PG8_KO(0)); PG8_STAGEA(PG8_SA(0, 0), PG8_KO(0), c00, c01); PG8_STAGEA(PG8_SA(0, 1), PG8_KO(0), c10, c11);
    if (wr == 1) PG8_BAR;
    PG8_WAIT_V(2); PG8_BAR;
    PG8_STAGEB(PG8_SB(1, 0), cB + PG8_KO(1)); PG8_STAGEA(PG8_SA(1, 0), PG8_KO(1), c00, c01); PG8_STAGEB(PG8_SB(1, 1), cB + hstep + PG8_KO(1));
    PG8_WAIT_V(6); PG8_BAR;
    for (;;) {
        const bool has_next = S.next(ui + 1, nxt, cur.e);
        const unsigned nB = has_next ? (unsigned)nxt.e * (unsigned)g.bstride + (unsigned)nxt.pn * tstep : cB;
        for (int t = 0; t < nt; t += 2) {
            const bool last = (t == nt - 2);
            if (last) { if (has_next) { PG8_ROWOFF(nxt, n00, n01, n10, n11); } else { n00 = c00; n01 = c01; n10 = c10; n11 = c11; } }
            const unsigned k1 = PG8_KO(t + 1);
            const unsigned k2 = PG8_KO(last ? 0 : t + 2), k3 = PG8_KO(last ? 1 : t + 3);
            const unsigned b2 = (last ? nB : cB) + k2, b3 = (last ? nB : cB) + k3;
            const unsigned s00 = last ? n00 : c00, s01 = last ? n01 : c01, s10 = last ? n10 : c10, s11 = last ? n11 : c11;
            PG8_LDB(B0, 0, 0); PG8_LDB(B1, 0, 1); PG8_SCHED; PG8_LDA(At, 0, 0); PG8_STAGEA(PG8_SA(1, 1), k1, c10, c11);
            PG8_WAIT_V(8); PG8_WAIT_L(0); PG8_BAR; PG8_MMA(0, 0, At, B0); PG8_MMA(0, 1, At, B1); PG8_BAR; PG8_SCHED;
            PG8_LDA(At, 0, 1); PG8_STAGEB(PG8_SB(0, 0), b2); PG8_STAGEB(PG8_SB(0, 1), b2 + hstep); PG8_STAGEA(PG8_SA(0, 0), k2, s00, s01);
            PG8_WAIT_V(8); PG8_WAIT_L(0); PG8_BAR; PG8_MMA(1, 0, At, B0); PG8_MMA(1, 1, At, B1); PG8_BAR; PG8_SCHED;
            PG8_LDB(B0, 1, 0); PG8_LDB(B1, 1, 1); PG8_SCHED; PG8_LDA(At, 1, 0); PG8_STAGEA(PG8_SA(0, 1), k2, s10, s11);
            PG8_WAIT_V(8); PG8_WAIT_L(0); PG8_BAR; PG8_MMA(0, 0, At, B0); PG8_MMA(0, 1, At, B1); PG8_BAR; PG8_SCHED;
            PG8_LDA(At, 1, 1); PG8_STAGEB(PG8_SB(1, 0), b3); PG8_STAGEB(PG8_SB(1, 1), b3 + hstep); PG8_STAGEA(PG8_SA(1, 0), k3, s00, s01);
            PG8_WAIT_V(8); PG8_WAIT_L(0); PG8_BAR; PG8_MMA(1, 0, At, B0); PG8_MMA(1, 1, At, B1); PG8_BAR; PG8_SCHED;
        }
        if (wr == 0) PG8_BAR;
        if constexpr (FP8) {
#pragma unroll
            for (int a = 0; a < 2; ++a)
#pragma unroll
                for (int b = 0; b < 2; ++b)
                    asm volatile("s_nop 15" : "+v"(acc[a][b][0][0]), "+v"(acc[a][b][0][1]), "+v"(acc[a][b][1][0]), "+v"(acc[a][b][1][1]), "+v"(acc[a][b][2][0]), "+v"(acc[a][b][2][1]), "+v"(acc[a][b][3][0]), "+v"(acc[a][b][3][1]));
        }
        E(acc, cur, wr, wc, fr, fq);
        if ((PROBE_SUB & 128) && FP8) E(acc, cur, wr, wc, fr, fq);
        if ((PROBE_SUB & 256) && !FP8) E(acc, cur, wr, wc, fr, fq);
        if (!has_next) break;
#pragma unroll
        for (int a = 0; a < 2; ++a)
#pragma unroll
            for (int b = 0; b < 2; ++b)
#pragma unroll
                for (int m = 0; m < 4; ++m)
#pragma unroll
                    for (int n = 0; n < 2; ++n) acc[a][b][m][n] = (f32x4){0.f, 0.f, 0.f, 0.f};
        cur = nxt; cB = nB; c00 = n00; c01 = n01; c10 = n10; c11 = n11; ++ui;
        if (wr == 1) PG8_BAR;
    }
    PG8_WAIT_V(0);
    PG8_BAR;
#undef PG8_KO
#undef PG8_SA
#undef PG8_SB
#undef PG8_STAGEB
#undef PG8_STAGEA
#undef PG8_LDA
#undef PG8_LDB
#undef PG8_MMA
#undef PG8_CAT
#undef PG8_WAIT_V
#undef PG8_WAIT_L
#undef PG8_BAR
#undef PG8_SCHED
#undef PG8_ROWOFF
}
}

#define XB_TMO      128
#define XB_XCNT(j)  (256  + 64 * (j))
#define XB_XSUB(j)  (1280 + 64 * (j))
#define XB_XGEN(j)  (2304 + 64 * (j))
#define XB_TOP      3328
#define XB_TOPGEN   3392
#define XCD_BAR_WORDS 3456
#define XB_SPIN_CAP (1u << 18)

__device__ __forceinline__ unsigned xb_ld(unsigned* p)              { return __hip_atomic_load(p, __ATOMIC_RELAXED, __HIP_MEMORY_SCOPE_AGENT); }
__device__ __forceinline__ unsigned xb_add(unsigned* p, unsigned v) { return __hip_atomic_fetch_add(p, v, __ATOMIC_RELAXED, __HIP_MEMORY_SCOPE_AGENT); }
__device__ __forceinline__ unsigned xb_xcc_id() { return (unsigned)__builtin_amdgcn_s_getreg((3 << 11) | 20) & 0xFu; }
#define XB_SPIN(cond, bar) do { unsigned _sp = 0; while (cond) { __builtin_amdgcn_s_sleep(1); \
    if ((++_sp & 255u) == 0u) { if (xb_ld(&(bar)[XB_TMO])) break; if (_sp > XB_SPIN_CAP) { atomicAdd(&(bar)[XB_TMO], 1u); break; } } } } while (0)

struct XcdBarrier { unsigned* bar; unsigned x; volatile LAS unsigned* st; };

__device__ __forceinline__ XcdBarrier xcd_barrier_post(unsigned* bar, volatile LAS unsigned* st) {
    XcdBarrier b; b.bar = bar; b.x = xb_xcc_id(); b.st = st;
    if (threadIdx.x == 0) (void)xb_add(&bar[XB_XCNT(b.x)], 1u);
    return b;
}
__device__ __forceinline__ void xcd_barrier_complete(unsigned* bar, unsigned x, unsigned& nloc, unsigned& nx) {
    const unsigned G = gridDim.x * gridDim.y * gridDim.z;
    unsigned sum, cnt, mine, sp = 0u;
    for (;;) {
        sum = 0u; cnt = 0u; mine = 0u;
#pragma unroll
        for (unsigned j = 0; j < 16; ++j) { const unsigned c = xb_ld(&bar[XB_XCNT(j)]); sum += c; cnt += (c > 0u) ? 1u : 0u; mine = (j == x) ? c : mine; }
        if (sum == G) break;
        __builtin_amdgcn_s_sleep(1);
        if ((++sp & 255u) == 0u) { if (xb_ld(&bar[XB_TMO])) break; if (sp > XB_SPIN_CAP) { atomicAdd(&bar[XB_TMO], 1u); break; } }
    }
    nloc = mine > 0u ? mine : 1u; nx = cnt > 0u ? cnt : 1u;
}
__device__ __forceinline__ void xcd_barrier(const XcdBarrier& b) {
    asm volatile("s_waitcnt vmcnt(0)" ::: "memory");
    __syncthreads();
    if (threadIdx.x == 0) {
        unsigned* bar = b.bar;
        __builtin_amdgcn_s_waitcnt(0);
        unsigned nloc = b.st[0], nx = b.st[1];
        if (nloc == 0u) { xcd_barrier_complete(bar, b.x, nloc, nx); b.st[0] = nloc; b.st[1] = nx; }
        const unsigned old = xb_add(&bar[XB_XSUB(b.x)], 1u);
        const unsigned gen = old / nloc;
        if (old + 1u == (gen + 1u) * nloc) {
            __builtin_amdgcn_fence(__ATOMIC_RELEASE, "agent");
            asm volatile("s_waitcnt vmcnt(0)" ::: "memory");
            const unsigned og = xb_add(&bar[XB_TOP], 1u);
            const unsigned tg = og / nx;
            if (og + 1u == (tg + 1u) * nx) xb_add(&bar[XB_TOPGEN], 1u);
            else XB_SPIN(xb_ld(&bar[XB_TOPGEN]) == tg, bar);
            __builtin_amdgcn_fence(__ATOMIC_ACQUIRE, "agent");
            xb_add(&bar[XB_XGEN(b.x)], 1u);
            asm volatile("s_waitcnt vmcnt(0)" ::: "memory");
        } else {
            XB_SPIN(xb_ld(&bar[XB_XGEN(b.x)]) == gen, bar);
            __builtin_amdgcn_fence(__ATOMIC_ACQUIRE, "agent");
            asm volatile("s_waitcnt vmcnt(0)" ::: "memory");
        }
    }
    __syncthreads();
}

struct Frame {
    LAS unsigned char* lds;
    volatile LAS unsigned* MISC;
    unsigned* ctl;
    int tid, lane, wave;
    int vcu, G;
    unsigned char* ws;
    const float* in[24];
    float* out;
};

__device__ __forceinline__ void p0_mod(Frame& F, int jb, int nb) {
    LAS float* sc = (LAS float*)F.lds;
    LAS float* part = (LAS float*)(F.lds + 32768);
    const float* c = F.in[1]; const float* w_ada = F.in[2]; const float* b_ada = F.in[3];
    float* MOD = (float*)(F.ws + WS_MOD);
    for (int i = F.tid; i < NB * D; i += NWAVES * 64) { const float v = c[i]; sc[i] = v / (1.0f + expf(-v)); }
    __syncthreads();
    for (int strip = jb; strip < 256; strip += nb) {
        const int col0 = strip * 48; const int kr = F.lane / 12, cq = F.lane % 12;
        f32x4 a0 = {0.f, 0.f, 0.f, 0.f}, a1 = a0, a2 = a0, a3 = a0;
        if (F.lane < 48) {
#pragma unroll 8
            for (int it = 0; it < 64; ++it) { const int k = F.wave * 256 + it * 4 + kr;
                const f32x4 wv = *(const f32x4*)(w_ada + (size_t)k * 12288 + col0 + 4 * cq);
                a0 += wv * sc[k]; a1 += wv * sc[2048 + k]; a2 += wv * sc[4096 + k]; a3 += wv * sc[6144 + k]; }
        }
        LAS f32x4* pp = (LAS f32x4*)(part + (F.wave * 64 + F.lane) * 16); pp[0] = a0; pp[1] = a1; pp[2] = a2; pp[3] = a3;
        __syncthreads();
        if (F.tid < 192) { const int b = F.tid / 48, col = F.tid % 48, q = col >> 2, i = col & 3; float s = b_ada[col0 + col];
            for (int w = 0; w < 8; ++w)
#pragma unroll
                for (int r = 0; r < 4; ++r) s += part[(w * 64 + r * 12 + q) * 16 + b * 4 + i];
            MOD[(size_t)b * 12288 + col0 + col] = s; }
        __syncthreads();
    }
}
__device__ __forceinline__ void tr_item(const float* src, int ldw, bf16* dst, int ldd, LAS float* scr, int lane) {
#pragma unroll 8
    for (int i = 0; i < 32; ++i) { const int kk = 2 * i + (lane >> 5); scr[kk * 33 + (lane & 31)] = src[(size_t)kk * ldw + (lane & 31)]; }
    LDS_WAIT(); asm volatile("" ::: "memory");
    const int c = lane & 7;
#pragma unroll
    for (int j = 0; j < 4; ++j) { const int n = (lane >> 3) + 8 * j; const LAS float* s = scr + (8 * c) * 33 + n;
        v4u o; o.x = pk2(s[0 * 33], s[1 * 33]); o.y = pk2(s[2 * 33], s[3 * 33]); o.z = pk2(s[4 * 33], s[5 * 33]); o.w = pk2(s[6 * 33], s[7 * 33]);
        *(v4u*)(dst + (size_t)n * ldd + 8 * c) = o; }
    LDS_WAIT(); asm volatile("" ::: "memory");
}
__device__ __forceinline__ void tr_item8(const float* src, int ldw, unsigned char* dst, int ldd, LAS unsigned char* tile, int lane) {
    const int c4 = lane & 15, r = lane >> 4;
#pragma unroll 1
    for (int hf = 0; hf < 2; ++hf) {
        f32x4 x[4][4];
#pragma unroll
        for (int q = 0; q < 4; ++q)
#pragma unroll
            for (int j = 0; j < 4; ++j) x[q][j] = __builtin_nontemporal_load((const f32x4*)(src + (size_t)(64 * hf + 16 * q + 4 * r + j) * ldw + 4 * c4));
#pragma unroll
        for (int q = 0; q < 4; ++q)
#pragma unroll
            for (int m = 0; m < 4; ++m) { const unsigned w = pk4_fp8(x[q][0][m] * W8_SCALE, x[q][1][m] * W8_SCALE, x[q][2][m] * W8_SCALE, x[q][3][m] * W8_SCALE);
                *(LAS unsigned*)(tile + (4 * c4 + m) * 128 + 16 * ((4 * hf + q) ^ (c4 & 7)) + 4 * r) = w; }
    }
    LDS_WAIT(); asm volatile("" ::: "memory");
#pragma unroll
    for (int it = 0; it < 8; ++it) { const int n = 8 * it + (lane >> 3), ch = lane & 7;
        const v4u v = *(const LAS v4u*)(tile + n * 128 + 16 * (ch ^ ((n >> 2) & 7)));
        __builtin_nontemporal_store(v, (v4u*)(dst + (size_t)n * ldd + 16 * ch)); }
    LDS_WAIT(); asm volatile("" ::: "memory");
}
__device__ __forceinline__ void p0_poolw(Frame& F, int jb, int nb) {
    LAS float* At = (LAS float*)F.lds;
    const float* w_in = F.in[4]; const float* w_pool = F.in[7]; const float* pscale = F.in[9]; unsigned char* WIN = F.ws + WS_WIN;
    for (int up = jb; up < 256; up += nb) {
        const int gq = up >> 6, k0 = 32 * (up & 63);
        for (int idx = F.tid; idx < 2048; idx += NWAVES * 64) { const int row = idx >> 6, c4 = idx & 63;
            *(LAS f32x4*)(At + row * 256 + 4 * c4) = *(const f32x4*)(w_in + (size_t)(k0 + row) * INW + gq * 256 + 4 * c4); }
        __syncthreads();
        const int half = F.tid >> 8, d = F.tid & 255; const LAS float* Ah = At + half * 4096; const float* wp = w_pool + (size_t)gq * 65536 + d;
        float acc[16];
#pragma unroll
        for (int r = 0; r < 16; ++r) acc[r] = 0.f;
#pragma unroll 2
        for (int c = 0; c < 256; c += 4) { const float w0 = wp[(c + 0) * 256], w1 = wp[(c + 1) * 256], w2 = wp[(c + 2) * 256], w3 = wp[(c + 3) * 256];
#pragma unroll
            for (int r = 0; r < 16; ++r) { const f32x4 a = *(const LAS f32x4*)(Ah + r * 256 + c); acc[r] += (a.x * w0 + a.y * w1) + (a.z * w2 + a.w * w3); } }
        const float sc = pscale[gq * 256 + d] * W8_SCALE; unsigned w[4];
#pragma unroll
        for (int i = 0; i < 4; ++i) w[i] = pk4_fp8(acc[4 * i] * sc, acc[4 * i + 1] * sc, acc[4 * i + 2] * sc, acc[4 * i + 3] * sc);
        unsigned char* dp = WIN + (size_t)(gq * 256 + d) * D + k0 + 16 * half;
        *(v4u*)dp = (v4u){w[0], w[1], w[2], w[3]};
        __syncthreads();
    }
}
__device__ __forceinline__ void expert_queue(Frame& F, int qword, int w0, int w1) {
    LAS float* scr = (LAS float*)(F.lds + F.wave * 16384);
    unsigned char* WGU = F.ws + WS_WGU; unsigned char* WDN = F.ws + WS_WDN;
    constexpr int I_E = 16 * 32 * 32, QCH = 4; const int NQ = (w1 - w0) * I_E; LAS int* qslot = (LAS int*)(F.lds + LDSCTL_OFF);
    for (;;) {
        __syncthreads();
        if (F.tid == 0) qslot[0] = (int)__hip_atomic_fetch_add(F.ctl + qword, (unsigned)(8 * QCH), RLX_AGENT);
        __syncthreads();
        const int base = __builtin_amdgcn_readfirstlane(qslot[0]);
        if (base >= NQ) break;
#pragma unroll 1
        for (int qi = 0; qi < QCH; ++qi) { const int r = base + F.wave + 8 * qi; if (r >= NQ) break;
          const int which = w0 + r / I_E; const int rr = r % I_E; const int e = rr / 512, q = rr % 512, kb = q / 32, nb = q % 32, n0 = 64 * nb;
          LAS unsigned char* tile = (LAS unsigned char*)scr;
          const size_t esrc = (size_t)e * D * D + (size_t)(128 * kb) * D + n0;
          if (which == 0)      tr_item8(F.in[16] + esrc, D, WGU + (size_t)e * 2 * D * D + (size_t)(256 * (n0 >> 7) + (n0 & 127)) * D + 128 * kb, D, tile, F.lane);
          else if (which == 1) tr_item8(F.in[18] + esrc, D, WGU + (size_t)e * 2 * D * D + (size_t)(256 * (n0 >> 7) + 128 + (n0 & 127)) * D + 128 * kb, D, tile, F.lane);
          else                 tr_item8(F.in[20] + esrc, D, WDN + (size_t)e * D * D + (size_t)n0 * D + 128 * kb, D, tile, F.lane); }
    }
}
__device__ __forceinline__ void p0_convert(Frame& F, int qword) {
    { const float* w_router = F.in[14]; float* WRT = (float*)(F.ws + WS_WRT);
      for (int idx = F.vcu * NWAVES * 64 + F.tid; idx < 2048 * 32; idx += F.G * NWAVES * 64) WRT[(idx & 31) * 2048 + (idx >> 5)] = w_router[idx]; }
    LAS float* scr = (LAS float*)(F.lds + F.wave * 16384);
    const int gw = F.vcu * NWAVES + F.wave, NGW = F.G * NWAVES;
    unsigned char* WIN = F.ws + WS_WIN; bf16* WOUT = (bf16*)(F.ws + WS_WOUT);
    constexpr int I_IN = 16 * 48, I_OUT = 32 * 64;
    constexpr int NSMALL = I_IN + I_OUT;
    for (int it = gw; it < NSMALL; it += NGW) {
        int r = it;
        if (r < I_IN) { const int kb = r / 48, nb = 16 + r % 48; const int scol = 64 * nb + (nb >= 48 ? 16 : 0);
            tr_item8(F.in[4] + (size_t)(128 * kb) * INW + scol, INW, WIN + (size_t)(64 * nb) * D + 128 * kb, D, (LAS unsigned char*)scr, F.lane); continue; } r -= I_IN;
        { const int kb = r / 64, nb = r % 64;
            tr_item(F.in[11] + (size_t)(64 * kb) * D + 32 * nb, D, WOUT + (size_t)(32 * nb) * D + 64 * kb, D, scr, F.lane); }
    }
    expert_queue(F, qword, 0, 2);
}

__device__ __forceinline__ void p1_modulate(Frame& F) {
    LAS float* wg = (LAS float*)F.lds;
    const float* w_in = F.in[4]; const float* x = F.in[0];
    const float* MOD = (const float*)(F.ws + WS_MOD); unsigned char* H = F.ws + WS_H; float* GK = (float*)(F.ws + WS_GK);
    for (int idx = F.tid; idx < 2048 * 16; idx += NWAVES * 64) { const int k = idx >> 4, r = idx & 15; wg[r * 2048 + k] = w_in[(size_t)k * INW + 3072 + r]; }
    __syncthreads();
    for (int blk = F.vcu; blk < T / 64; blk += F.G) {
        const int b = blk / 64;
        const float* sh = MOD + (size_t)b * 12288; const float* scl = sh + 2048;
        f32x4 shv[8], scv[8];
#pragma unroll
        for (int j = 0; j < 8; ++j) { shv[j] = *(const f32x4*)(sh + 256 * j + 4 * F.lane); scv[j] = *(const f32x4*)(scl + 256 * j + 4 * F.lane) + 1.0f; }
        f32x4 vn[8];
        { const f32x4* xr = (const f32x4*)(x + (size_t)(blk * 64 + F.wave) * D) + F.lane;
#pragma unroll
          for (int j = 0; j < 8; ++j) vn[j] = xr[64 * j]; }
#pragma unroll 1
        for (int rr = 0; rr < 8; ++rr) {
            const int m = blk * 64 + rr * 8 + F.wave;
            f32x4 v[8]; float s = 0.f;
#pragma unroll
            for (int j = 0; j < 8; ++j) { v[j] = vn[j]; s += (v[j].x + v[j].y) + (v[j].z + v[j].w); }
            if (rr < 7) { const f32x4* xr = (const f32x4*)(x + (size_t)(m + 8) * D) + F.lane;
#pragma unroll
                for (int j = 0; j < 8; ++j) vn[j] = xr[64 * j]; }
            const float mean = wave_sum(s) * (1.f / D); float s2 = 0.f;
#pragma unroll
            for (int j = 0; j < 8; ++j) { v[j] = v[j] - mean; s2 += (v[j].x * v[j].x + v[j].y * v[j].y) + (v[j].z * v[j].z + v[j].w * v[j].w); }
            const float rstd = 1.f / sqrtf(wave_sum(s2) * (1.f / D) + LN_EPS);
            unsigned* o4 = (unsigned*)(H + (size_t)m * D) + F.lane;
#pragma unroll
            for (int j = 0; j < 8; ++j) { v[j] = v[j] * rstd * scv[j] + shv[j]; o4[64 * j] = pk4_fp8(v[j].x, v[j].y, v[j].z, v[j].w); }
            float res = 0.f;
#pragma unroll 1
            for (int r = 0; r < 16; ++r) { float a = 0.f;
#pragma unroll
                for (int j = 0; j < 8; ++j) { const f32x4 w4 = *(const LAS f32x4*)(wg + r * 2048 + 256 * j + 4 * F.lane); a += (v[j].x * w4.x + v[j].y * w4.y) + (v[j].z * w4.z + v[j].w * w4.w); }
                a = wave_sum(a); if (F.lane == r) res = a; }
            if (F.lane < 16) GK[(size_t)m * 16 + F.lane] = res;
        }
    }
}

__device__ __forceinline__ void p3_pool_filter(Frame& F) {
    const bf16* PROJ = (const bf16*)(F.ws + WS_PROJ); bf16* MIX = (bf16*)(F.ws + WS_MIX); const float* b_pool = F.in[8]; const float* pscale = F.in[9];
    for (int tile = F.vcu; tile < T / 64; tile += F.G) {
        const int gq = F.wave & 3, rh = F.wave >> 2, c8 = F.lane & 31, sub = F.lane >> 5;
        const int w = 2 << gq, ch = gq * 256 + c8 * 8, t0 = tile * 64, pos0 = t0 % SEQ, i0 = rh * 32 + sub * 16;
        float bs[8], sm[8];
#pragma unroll
        for (int i = 0; i < 8; ++i) { bs[i] = b_pool[ch + i] * pscale[ch + i]; sm[i] = 0.f; }
        for (int j = 1; j < w; ++j) if (pos0 + i0 - j >= 0) { const v4u v = *(const v4u*)(PROJ + (size_t)(t0 + i0 - j) * NPROJ + ch);
            sm[0] += bflo(v.x); sm[1] += bfhi(v.x); sm[2] += bflo(v.y); sm[3] += bfhi(v.y); sm[4] += bflo(v.z); sm[5] += bfhi(v.z); sm[6] += bflo(v.w); sm[7] += bfhi(v.w); }
#pragma unroll 4
        for (int ii = 0; ii < 16; ++ii) { const int i = i0 + ii; const size_t row = (size_t)(t0 + i);
            const v4u v = *(const v4u*)(PROJ + row * NPROJ + ch);
            const float cu[8] = {bflo(v.x), bfhi(v.x), bflo(v.y), bfhi(v.y), bflo(v.z), bfhi(v.z), bflo(v.w), bfhi(v.w)};
            const int pc = pos0 + i + 1; const float inv = 1.0f / (float)(pc < w ? pc : w); float o[8];
#pragma unroll
            for (int k = 0; k < 8; ++k) { sm[k] += cu[k]; o[k] = sm[k] * inv - cu[k] + bs[k]; }
            *(v4u*)(MIX + row * D + ch) = (v4u){pk2(o[0], o[1]), pk2(o[2], o[3]), pk2(o[4], o[5]), pk2(o[6], o[7])};
            if (pos0 + i - w + 1 >= 0) { const v4u d = *(const v4u*)(PROJ + (row - w + 1) * NPROJ + ch);
                sm[0] -= bflo(d.x); sm[1] -= bfhi(d.x); sm[2] -= bflo(d.y); sm[3] -= bfhi(d.y); sm[4] -= bflo(d.z); sm[5] -= bfhi(d.z); sm[6] -= bflo(d.w); sm[7] -= bfhi(d.w); } }
    }
}
__device__ __forceinline__ void p3_gla_prep(Frame& F) {
    LAS float* glr = (LAS float*)F.lds;
    const bf16* PROJ = (const bf16*)(F.ws + WS_PROJ); bf16* QKH = (bf16*)(F.ws + WS_QKH); const float* GK = (const float*)(F.ws + WS_GK); const float* w_gk = F.in[5]; const float* b_gk = F.in[6];
    bf16* KHT = (bf16*)(F.ws + WS_KHT); bf16* VT = (bf16*)(F.ws + WS_VT); bf16* VT5 = (bf16*)(F.ws + WS_VT5); float* DEC = (float*)(F.ws + WS_DEC);
    for (int ug = F.vcu; ug < 256; ug += F.G) {
        for (int idx = F.tid; idx < 4096; idx += NWAVES * 64) { const int u = 4 * ug + (idx >> 10), bh = u >> 6, n = u & 63; const int t0 = (bh >> 2) * SEQ + n * 64; glr[idx] = GK[(size_t)t0 * 16 + (idx & 1023)]; }
        __syncthreads();
        const int ci = F.tid >> 7, u = 4 * ug + ci, bh = u >> 6, n = u & 63, h = bh & 3, t0 = (bh >> 2) * SEQ + n * 64;
        { const int d = F.tid & 127; float wk[16];
#pragma unroll
          for (int r = 0; r < 16; ++r) wk[r] = w_gk[r * 512 + h * 128 + d];
          const float bk = b_gk[h * 128 + d];
          const bf16* qp = PROJ + (size_t)t0 * NPROJ + C_Q + h * 128 + d; const bf16* kp = PROJ + (size_t)t0 * NPROJ + C_K + h * 128 + d;
          bf16* qo = QKH + (size_t)t0 * 1024 + h * 128 + d; bf16* ko = qo + 512;
          float run = 0.f; unsigned kpk[32];
#pragma unroll
          for (int tb = 0; tb < 64; tb += 16) { bf16 qv[16], kv[16];
#pragma unroll
              for (int i = 0; i < 16; ++i) { qv[i] = qp[(size_t)(tb + i) * NPROJ]; kv[i] = kp[(size_t)(tb + i) * NPROJ]; }
#pragma unroll
              for (int i = 0; i < 16; ++i) { const int t = tb + i; const LAS f32x4* gp = (const LAS f32x4*)(glr + ci * 1024 + t * 16);
                  const f32x4 g0 = gp[0], g1 = gp[1], g2 = gp[2], g3 = gp[3];
                  float xv = bk + ((g0.x * wk[0] + g0.y * wk[1]) + (g0.z * wk[2] + g0.w * wk[3])) + ((g1.x * wk[4] + g1.y * wk[5]) + (g1.z * wk[6] + g1.w * wk[7]))
                                + ((g2.x * wk[8] + g2.y * wk[9]) + (g2.z * wk[10] + g2.w * wk[11])) + ((g3.x * wk[12] + g3.y * wk[13]) + (g3.z * wk[14] + g3.w * wk[15]));
                  const float ls = fminf(xv, 0.f) - __logf(1.0f + __expf(-fabsf(xv)));
                  run += ls * (1.0f / 16.0f);
                  const float e = __expf(run), ei = __expf(-run);
                  const unsigned qh = f2bf(bf2f(qv[i]) * e * 0.08838834764831845f), kh = f2bf(bf2f(kv[i]) * ei);
                  qo[(size_t)t * 1024] = (bf16)qh; ko[(size_t)t * 1024] = (bf16)kh;
                  if (t & 1) kpk[t >> 1] |= kh << 16; else kpk[t >> 1] = kh; } }
          DEC[(size_t)u * 128 + d] = __expf(run);
#pragma unroll
          for (int i = 0; i < 8; ++i) { const int kk = i >> 2, q = i & 3;
              *(v4u*)(KHT + ((((size_t)u * 8 + (d >> 4)) * 2 + kk) * 64 + (d & 15) + 16 * q) * 8) = (v4u){kpk[4 * i], kpk[4 * i + 1], kpk[4 * i + 2], kpk[4 * i + 3]}; } }
        { const int dvp = F.tid & 127;
          const unsigned* vp = (const unsigned*)(PROJ + (size_t)t0 * NPROJ + C_V + h * 256 + 2 * dvp);
#pragma unroll 1
          for (int hb = 0; hb < 2; ++hb) { unsigned vv[32];
#pragma unroll
              for (int i = 0; i < 32; ++i) vv[i] = vp[(size_t)(hb * 32 + i) * (NPROJ / 2)];
              unsigned lo[16], hi[16];
#pragma unroll
              for (int i = 0; i < 16; ++i) { lo[i] = (vv[2 * i] & 0xffffu) | (vv[2 * i + 1] << 16); hi[i] = (vv[2 * i] >> 16) | (vv[2 * i + 1] & 0xffff0000u); }
              const int dv0 = 2 * dvp, dvt = dv0 >> 4;
#pragma unroll
              for (int q = 0; q < 4; ++q) { const size_t f0 = ((((size_t)u * 16 + dvt) * 2 + hb) * 64 + (dv0 & 15) + 16 * q) * 8;
                  *(v4u*)(VT + f0) = (v4u){lo[4 * q], lo[4 * q + 1], lo[4 * q + 2], lo[4 * q + 3]}; *(v4u*)(VT + f0 + 8) = (v4u){hi[4 * q], hi[4 * q + 1], hi[4 * q + 2], hi[4 * q + 3]};
                  *(v4u*)(VT5 + f0) = (v4u){lo[2 * q], lo[2 * q + 1], lo[8 + 2 * q], lo[8 + 2 * q + 1]}; *(v4u*)(VT5 + f0 + 8) = (v4u){hi[2 * q], hi[2 * q + 1], hi[8 + 2 * q], hi[8 + 2 * q + 1]}; } } }
        __syncthreads();
    }
}
__device__ __forceinline__ void p4_scan(Frame& F) {
    const bf16* KHT = (const bf16*)(F.ws + WS_KHT); const bf16* VT = (const bf16*)(F.ws + WS_VT); const float* DEC = (const float*)(F.ws + WS_DEC); bf16* ST = (bf16*)(F.ws + WS_ST);
    const int l15 = F.lane & 15, lq = F.lane >> 4;
    if (F.wave < 4)
    for (int gw = F.vcu * 4 + F.wave; gw < 1024; gw += F.G * 4) {
        const int bh = gw >> 6, dvt = (gw >> 2) & 15, kp = gw & 3;
        const bf16* vt = VT + (((size_t)bh * 64 * 16 + dvt) * 2 * 64 + F.lane) * 8;
        const bf16* kt = KHT + (((size_t)bh * 64 * 8 + 2 * kp) * 2 * 64 + F.lane) * 8;
        const float* de = DEC + (size_t)bh * 64 * 128 + kp * 32 + 4 * lq;
        bf16* st = ST + (size_t)bh * 64 * 32768 + ((size_t)(dvt * 4 + kp) * 64 + F.lane) * 8;
        f32x4 S0 = {0.f, 0.f, 0.f, 0.f}, S1 = S0;
#pragma unroll 4
        for (int n = 0; n < 64; ++n) {
            const bf16x8 b0 = *(const bf16x8*)(vt + (size_t)n * 16384), b1 = *(const bf16x8*)(vt + (size_t)n * 16384 + 512);
            const bf16x8 a00 = *(const bf16x8*)(kt + (size_t)n * 8192), a01 = *(const bf16x8*)(kt + (size_t)n * 8192 + 512);
            const bf16x8 a10 = *(const bf16x8*)(kt + (size_t)n * 8192 + 1024), a11 = *(const bf16x8*)(kt + (size_t)n * 8192 + 1536);
            const f32x4 d0 = *(const f32x4*)(de + (size_t)n * 128), d1 = *(const f32x4*)(de + (size_t)n * 128 + 16);
            *(v4u*)(st + (size_t)n * 32768) = (v4u){pk2(S0[0], S0[1]), pk2(S0[2], S0[3]), pk2(S1[0], S1[1]), pk2(S1[2], S1[3])};
            S0 = mma16(a00, b0, S0); S0 = mma16(a01, b1, S0); S0 = S0 * d0;
            S1 = mma16(a10, b0, S1); S1 = mma16(a11, b1, S1); S1 = S1 * d1; }
    }
}
__device__ __forceinline__ void p5_gla_out(Frame& F) {
    const bf16* PROJ = (const bf16*)(F.ws + WS_PROJ); const bf16* QKH = (const bf16*)(F.ws + WS_QKH); const bf16* VT5 = (const bf16*)(F.ws + WS_VT5); const bf16* ST = (const bf16*)(F.ws + WS_ST); bf16* MIX = (bf16*)(F.ws + WS_MIX); const float* norm_w = F.in[10];
    const int l15 = F.lane & 15, lq = F.lane >> 4;
    for (int wu = F.vcu * NWAVES + F.wave; wu < 4096; wu += F.G * NWAVES) {
        const int u = wu >> 2, tt = wu & 3, bh = u >> 6, n = u & 63, h = bh & 3, t0 = (bh >> 2) * SEQ + n * 64;
        const size_t trow = (size_t)(t0 + 16 * tt + l15);
        bf16x8 qf[4];
#pragma unroll
        for (int kk = 0; kk < 4; ++kk) { const bf16* qp_ = QKH + trow * 1024 + h * 128 + 32 * kk + 4 * lq; const v2u qa = *(const v2u*)qp_, qb = *(const v2u*)(qp_ + 16);
            qf[kk] = __builtin_bit_cast(bf16x8, (v4u){qa.x, qa.y, qb.x, qb.y}); }
        unsigned pt[4][2];
#pragma unroll
        for (int st = 0; st < 4; ++st) { pt[st][0] = 0u; pt[st][1] = 0u;
            if (st <= tt) { f32x4 a = {0.f, 0.f, 0.f, 0.f};
#pragma unroll
                for (int kk = 0; kk < 4; ++kk) { const bf16* kp_ = QKH + (size_t)(t0 + 16 * st + l15) * 1024 + 512 + h * 128 + 32 * kk + 4 * lq; const v2u ka = *(const v2u*)kp_, kb2 = *(const v2u*)(kp_ + 16);
                    a = mma16(__builtin_bit_cast(bf16x8, (v4u){ka.x, ka.y, kb2.x, kb2.y}), qf[kk], a); }
                const int sb = 16 * st + 4 * lq, tq = 16 * tt + l15;
                pt[st][0] = pk2(sb + 0 <= tq ? a[0] : 0.f, sb + 1 <= tq ? a[1] : 0.f); pt[st][1] = pk2(sb + 2 <= tq ? a[2] : 0.f, sb + 3 <= tq ? a[3] : 0.f); } }
        const bf16x8 pf0 = __builtin_bit_cast(bf16x8, (v4u){pt[0][0], pt[0][1], pt[1][0], pt[1][1]}), pf1 = __builtin_bit_cast(bf16x8, (v4u){pt[2][0], pt[2][1], pt[3][0], pt[3][1]});
        f32x4 o[16];
        bf16x8 sfb[4][4]; v4u vfb[4][2];
#define P5_LOAD(buf, dvt_) do { const bf16* sp_ = ST + (size_t)u * 32768 + ((size_t)(dvt_) * 256 + F.lane) * 8; const bf16* vp_ = VT5 + (((size_t)u * 16 + (dvt_)) * 2 * 64 + F.lane) * 8; \
            _Pragma("unroll") for (int kk = 0; kk < 4; ++kk) sfb[buf][kk] = *(const bf16x8*)(sp_ + 512 * kk); \
            vfb[buf][0] = *(const v4u*)vp_; if (tt >= 2) vfb[buf][1] = *(const v4u*)(vp_ + 512); } while (0)
        P5_LOAD(0, 0); P5_LOAD(1, 1); P5_LOAD(2, 2);
#pragma unroll
        for (int dvt = 0; dvt < 16; ++dvt) { const int cb = dvt & 3;
            if (dvt + 3 < 16) P5_LOAD((dvt + 3) & 3, dvt + 3);
            f32x4 a = {0.f, 0.f, 0.f, 0.f};
#pragma unroll
            for (int kk = 0; kk < 4; ++kk) a = mma16(sfb[cb][kk], qf[kk], a);
            a = mma16(__builtin_bit_cast(bf16x8, vfb[cb][0]), pf0, a);
            if (tt >= 2) a = mma16(__builtin_bit_cast(bf16x8, vfb[cb][1]), pf1, a);
            o[dvt] = a; }
#undef P5_LOAD
        float ss = 0.f;
#pragma unroll
        for (int dvt = 0; dvt < 16; ++dvt) ss += (o[dvt][0] * o[dvt][0] + o[dvt][1] * o[dvt][1]) + (o[dvt][2] * o[dvt][2] + o[dvt][3] * o[dvt][3]);
        ss += __shfl_xor(ss, 16); ss += __shfl_xor(ss, 32);
        const float rinv = 1.0f / sqrtf(ss * (1.0f / 256.0f) + 1e-6f);
#pragma unroll
        for (int dvt = 0; dvt < 16; ++dvt) { const int dv0 = dvt * 16 + 4 * lq;
            const f32x4 nw = *(const f32x4*)(norm_w + dv0); const v2u gv = *(const v2u*)(PROJ + trow * NPROJ + C_G + h * 256 + dv0);
            const float g0 = bflo(gv.x), g1 = bfhi(gv.x), g2 = bflo(gv.y), g3 = bfhi(gv.y);
            v2u w; w.x = pk2(o[dvt][0] * rinv * nw.x * g0 * __builtin_amdgcn_rcpf(1.0f + __expf(-g0)), o[dvt][1] * rinv * nw.y * g1 * __builtin_amdgcn_rcpf(1.0f + __expf(-g1)));
            w.y = pk2(o[dvt][2] * rinv * nw.z * g2 * __builtin_amdgcn_rcpf(1.0f + __expf(-g2)), o[dvt][3] * rinv * nw.w * g3 * __builtin_amdgcn_rcpf(1.0f + __expf(-g3)));
            *(v2u*)(MIX + trow * D + 1024 + h * 256 + dv0) = w; }
    }
}

constexpr int HS_LD = 2052;
constexpr int L7_HS = 0, L7_PART = 131584, L7_RED = 147968, L7_AE = 150016, L7_AW = 151040, L7_WC = 152064, L7_EB = 153088;
__device__ __forceinline__ void p7_ln_router(Frame& F) {
    LAS float* hs = (LAS float*)(F.lds + L7_HS); LAS float* part = (LAS float*)(F.lds + L7_PART); LAS float* red = (LAS float*)(F.lds + L7_RED);
    LAS int* ae = (LAS int*)(F.lds + L7_AE); LAS float* aw = (LAS float*)(F.lds + L7_AW); LAS int* wcn = (LAS int*)(F.lds + L7_WC); LAS int* eb = (LAS int*)(F.lds + L7_EB);
    const bf16* YG = (const bf16*)(F.ws + WS_Z); const float* X = F.in[0]; bf16* X1B = (bf16*)(F.ws + WS_X1); unsigned char* H2 = F.ws + WS_H;
    const float* MOD = (const float*)(F.ws + WS_MOD); const float* WRT = (const float*)(F.ws + WS_WRT); const float* b_router = F.in[15];
    int* TOPE = (int*)(F.ws + WS_TOPE); float* TOPW = (float*)(F.ws + WS_TOPW); int* RANK = (int*)(F.ws + WS_RANK); int* STOK = (int*)(F.ws + WS_STOK);
    const int l15 = F.lane & 15, lq = F.lane >> 4;
    const int col = 256 * F.wave + 4 * F.lane;
    const f32x4 lng = *(const f32x4*)(F.in[12] + col), lnb = *(const f32x4*)(F.in[13] + col);
#define P7_STATS(which, ps1, ps2, meanv, rstdv) do { \
        _Pragma("unroll") for (int r = 0; r < 16; ++r) { const float t1 = wave_sum(ps1[r]), t2 = wave_sum(ps2[r]); if (F.lane == 0) { red[((which) * 2 + 0) * 128 + F.wave * 16 + r] = t1; red[((which) * 2 + 1) * 128 + F.wave * 16 + r] = t2; } } \
        __syncthreads(); \
        { float a1 = 0.f, a2 = 0.f; if (F.lane < 16) { _Pragma("unroll") for (int w = 0; w < 8; ++w) { a1 += red[((which) * 2 + 0) * 128 + w * 16 + F.lane]; a2 += red[((which) * 2 + 1) * 128 + w * 16 + F.lane]; } } \
          meanv = a1 * (1.f / D); rstdv = 1.f / sqrtf(fmaxf(a2 * (1.f / D) - meanv * meanv, 0.f) + LN_EPS); } } while (0)
    for (int blk = F.vcu; blk < T / 64; blk += F.G) {
        const int b = blk / 64; const f32x4 sh2 = *(const f32x4*)(MOD + (size_t)b * 12288 + 3 * 2048 + col), sc2 = *(const f32x4*)(MOD + (size_t)b * 12288 + 4 * 2048 + col) + 1.0f;
#pragma unroll 1
        for (int sb = 0; sb < 4; ++sb) {
            const int m0 = blk * 64 + sb * 16;
            f32x4 z[16]; float ps1[16], ps2[16];
            { f32x4 xv[16]; v2u yv[16];
#pragma unroll
              for (int r = 0; r < 16; ++r) { xv[r] = *(const f32x4*)(X + (size_t)(m0 + r) * D + col); yv[r] = *(const v2u*)(YG + (size_t)(m0 + r) * D + col); }
#pragma unroll
              for (int r = 0; r < 16; ++r) { z[r] = xv[r] * ALPHA + (f32x4){bflo(yv[r].x), bfhi(yv[r].x), bflo(yv[r].y), bfhi(yv[r].y)};
                  ps1[r] = (z[r].x + z[r].y) + (z[r].z + z[r].w); ps2[r] = (z[r].x * z[r].x + z[r].y * z[r].y) + (z[r].z * z[r].z + z[r].w * z[r].w); } }
            float meanv, rstdv;
            P7_STATS(0, ps1, ps2, meanv, rstdv);
#pragma unroll
            for (int r = 0; r < 16; ++r) { const float mu = rdlane(meanv, r), rs = rdlane(rstdv, r);
                z[r] = (z[r] - mu) * rs * lng + lnb;
                *(v2u*)(X1B + (size_t)(m0 + r) * D + col) = (v2u){pk2(z[r].x, z[r].y), pk2(z[r].z, z[r].w)};
                ps1[r] = (z[r].x + z[r].y) + (z[r].z + z[r].w); ps2[r] = (z[r].x * z[r].x + z[r].y * z[r].y) + (z[r].z * z[r].z + z[r].w * z[r].w); }
            P7_STATS(1, ps1, ps2, meanv, rstdv);
#pragma unroll
            for (int r = 0; r < 16; ++r) { const float mu = rdlane(meanv, r), rs = rdlane(rstdv, r);
                const f32x4 h = (z[r] - mu) * rs * sc2 + sh2;
                *(unsigned*)(H2 + (size_t)(m0 + r) * D + col) = pk4_fp8(h.x, h.y, h.z, h.w);
                *(LAS f32x4*)(hs + r * HS_LD + col) = h; }
            asm volatile("s_waitcnt lgkmcnt(0)" ::: "memory");
            { f32x4 a0 = {0.f, 0.f, 0.f, 0.f}, a1 = a0;
#pragma unroll 8
              for (int kb = 0; kb < 16; ++kb) { const int k0 = 256 * F.wave + 16 * kb + 4 * lq;
                  const f32x4 af = *(const LAS f32x4*)(hs + l15 * HS_LD + k0);
                  const f32x4 b0 = ldg<f32x4>(WRT, ((unsigned)l15 * 2048u + (unsigned)k0) * 4u), b1 = ldg<f32x4>(WRT, ((unsigned)(16 + l15) * 2048u + (unsigned)k0) * 4u);
#pragma unroll
                  for (int sI = 0; sI < 4; ++sI) { a0 = __builtin_amdgcn_mfma_f32_16x16x4f32(af[sI], b0[sI], a0, 0, 0, 0); a1 = __builtin_amdgcn_mfma_f32_16x16x4f32(af[sI], b1[sI], a1, 0, 0, 0); } }
#pragma unroll
              for (int rg = 0; rg < 4; ++rg) { part[(F.wave * 16 + 4 * lq + rg) * 32 + l15] = a0[rg]; part[(F.wave * 16 + 4 * lq + rg) * 32 + 16 + l15] = a1[rg]; } }
            __syncthreads();
#pragma unroll 1
            for (int rr = 0; rr < 2; ++rr) { const int row = F.wave + 8 * rr;
              float lgv = -3.0e38f;
              if (F.lane < 32) { lgv = b_router[F.lane];
#pragma unroll
                  for (int w = 0; w < 8; ++w) lgv += part[(w * 16 + row) * 32 + F.lane]; }
              int cnt = 0;
#pragma unroll
              for (int e = 0; e < 32; ++e) { const float o = rdlane(lgv, e); cnt += (o > lgv || (o == lgv && e < F.lane)) ? 1 : 0; }
              float sv[4]; int si[4];
#pragma unroll
              for (int k = 0; k < 4; ++k) { const unsigned long long mk = __ballot(F.lane < 32 && cnt == k); si[k] = (int)__builtin_ctzll(mk); sv[k] = rdlane(lgv, si[k]); }
              const float e1 = expf(sv[1] - sv[0]), e2 = expf(sv[2] - sv[0]), e3 = expf(sv[3] - sv[0]); const float inv = 1.0f / (1.0f + e1 + e2 + e3);
              if (F.lane == 0) { const int base = (sb * 16 + row) * 4;
                  ae[base + 0] = si[0]; ae[base + 1] = si[1]; ae[base + 2] = si[2]; ae[base + 3] = si[3];
                  aw[base + 0] = inv; aw[base + 1] = e1 * inv; aw[base + 2] = e2 * inv; aw[base + 3] = e3 * inv; } }
            __syncthreads();
        }
        int myE = 0, lr = 0;
        if (F.wave < 4) { myE = ae[F.tid]; int wc = 0;
#pragma unroll
            for (int e = 0; e < 32; ++e) { const unsigned long long mk = __ballot(myE == e); if (myE == e) lr = __builtin_popcountll(mk & ((1ull << F.lane) - 1ull)); if (F.lane == e) wc = __builtin_popcountll(mk); }
            if (F.lane < 32) wcn[F.wave * 32 + F.lane] = wc; }
        __syncthreads();
        if (F.tid < 32) { const int c0 = wcn[F.tid], c1 = wcn[32 + F.tid], c2 = wcn[64 + F.tid], c3 = wcn[96 + F.tid], tot = c0 + c1 + c2 + c3;
            const int base = tot ? (int)__hip_atomic_fetch_add(F.ctl + CW_CNT + 64 * F.tid, (unsigned)tot, RLX_AGENT) : 0;
            eb[F.tid] = base; eb[32 + F.tid] = base + c0; eb[64 + F.tid] = base + c0 + c1; eb[96 + F.tid] = base + c0 + c1 + c2; }
        __syncthreads();
        if (F.wave < 4) { const int rk = eb[F.wave * 32 + myE] + lr, m = blk * 64 + (F.tid >> 2);
            TOPE[(size_t)blk * 256 + F.tid] = myE; TOPW[(size_t)blk * 256 + F.tid] = aw[F.tid]; RANK[(size_t)blk * 256 + F.tid] = rk;
            STOK[(size_t)myE * ECAP + rk] = m; }
        __syncthreads();
    }
#undef P7_STATS
}
__device__ __forceinline__ void build_ts(Frame& F) {
    LAS int* ts = (LAS int*)(F.lds + TS_OFF);
    if (F.tid < 64) {
        const unsigned c = (F.lane < NE) ? __hip_atomic_load(F.ctl + CW_CNT + 64 * (F.lane & 31), RLX_AGENT) : 0u;
        const int nt = (int)((c + 255u) >> 8); int inc = nt;
#pragma unroll
        for (int o = 1; o < 32; o <<= 1) { const int v = __shfl_up(inc, o); if (F.lane >= o) inc += v; }
        if (F.lane < NE) ts[F.lane] = inc - nt;
        if (F.lane == NE - 1) ts[NE] = inc;
    }
    __syncthreads();
}
__device__ __forceinline__ void p10_final(Frame& F) {
    build_ts(F);
    const LAS int* ts = (const LAS int*)(F.lds + TS_OFF);
    LAS float* pg2 = (LAS float*)F.lds; LAS float* plg = pg2 + 4 * 2048; LAS float* plb = plg + 2048;
    const bf16* X1B = (const bf16*)(F.ws + WS_X1); const bf16* Y = (const bf16*)(F.ws + WS_Y); const float* MOD = (const float*)(F.ws + WS_MOD);
    const int* TOPE = (const int*)(F.ws + WS_TOPE); const float* TOPW = (const float*)(F.ws + WS_TOPW); const int* RANK = (const int*)(F.ws + WS_RANK);
    for (int i = F.tid; i < 4 * 2048; i += NWAVES * 64) pg2[i] = MOD[(size_t)(i >> 11) * 12288 + 5 * 2048 + (i & 2047)];
    for (int i = F.tid; i < 2048; i += NWAVES * 64) { plg[i] = F.in[22][i]; plb[i] = F.in[23][i]; }
    __syncthreads();
    const int gw = F.vcu * NWAVES + F.wave, NGW = F.G * NWAVES;
    int4 e4n = {0, 0, 0, 0}, r4n = e4n; f32x4 w4n = {0.f, 0.f, 0.f, 0.f};
    if (gw < T) { e4n = *(const int4*)(TOPE + (size_t)gw * 4); r4n = *(const int4*)(RANK + (size_t)gw * 4); w4n = *(const f32x4*)(TOPW + (size_t)gw * 4); }
#pragma unroll 1
    for (int m = gw; m < T; m += NGW) {
        const int b = m / SEQ;
        const int4 e4 = e4n, r4 = r4n; const f32x4 w4 = w4n;
        if (m + NGW < T) { e4n = *(const int4*)(TOPE + (size_t)(m + NGW) * 4); r4n = *(const int4*)(RANK + (size_t)(m + NGW) * 4); w4n = *(const f32x4*)(TOPW + (size_t)(m + NGW) * 4); }
        const v4u* y0 = (const v4u*)(Y + ((size_t)ts[e4.x] * 256 + r4.x) * D) + F.lane; const v4u* y1 = (const v4u*)(Y + ((size_t)ts[e4.y] * 256 + r4.y) * D) + F.lane;
        const v4u* y2 = (const v4u*)(Y + ((size_t)ts[e4.z] * 256 + r4.z) * D) + F.lane; const v4u* y3 = (const v4u*)(Y + ((size_t)ts[e4.w] * 256 + r4.w) * D) + F.lane;
        const v4u* xr = (const v4u*)(X1B + (size_t)m * D) + F.lane;
        v4u ya[4], yb[4], yc[4], yd[4], xv[4];
#pragma unroll
        for (int j = 0; j < 4; ++j) { ya[j] = y0[64 * j]; yb[j] = y1[64 * j]; yc[j] = y2[64 * j]; yd[j] = y3[64 * j]; xv[j] = xr[64 * j]; }
        float acc[4][8]; float s = 0.f;
#pragma unroll
        for (int j = 0; j < 4; ++j) { const LAS float* gp = pg2 + b * 2048 + 512 * j + 8 * F.lane; const f32x4 g0 = *(const LAS f32x4*)gp, g1 = *(const LAS f32x4*)(gp + 4);
            const float gg[8] = {g0.x, g0.y, g0.z, g0.w, g1.x, g1.y, g1.z, g1.w};
            const unsigned aw[4] = {ya[j].x, ya[j].y, ya[j].z, ya[j].w}, bw[4] = {yb[j].x, yb[j].y, yb[j].z, yb[j].w}, cw[4] = {yc[j].x, yc[j].y, yc[j].z, yc[j].w}, dw[4] = {yd[j].x, yd[j].y, yd[j].z, yd[j].w}, xw[4] = {xv[j].x, xv[j].y, xv[j].z, xv[j].w};
#pragma unroll
            for (int q = 0; q < 4; ++q) {
                const float m0 = (w4.x * bflo(aw[q]) + w4.y * bflo(bw[q])) + (w4.z * bflo(cw[q]) + w4.w * bflo(dw[q]));
                const float m1 = (w4.x * bfhi(aw[q]) + w4.y * bfhi(bw[q])) + (w4.z * bfhi(cw[q]) + w4.w * bfhi(dw[q]));
                acc[j][2 * q] = bflo(xw[q]) * ALPHA + gg[2 * q] * m0; acc[j][2 * q + 1] = bfhi(xw[q]) * ALPHA + gg[2 * q + 1] * m1;
                s += acc[j][2 * q] + acc[j][2 * q + 1]; } }
        const float mean = wave_sum(s) * (1.f / D); float s2 = 0.f;
#pragma unroll
        for (int j = 0; j < 4; ++j)
#pragma unroll
            for (int i = 0; i < 8; ++i) { acc[j][i] -= mean; s2 += acc[j][i] * acc[j][i]; }
        const float rstd = 1.f / sqrtf(wave_sum(s2) * (1.f / D) + LN_EPS);
        float* orow = F.out + (size_t)m * D + 8 * F.lane;
#pragma unroll
        for (int j = 0; j < 4; ++j) { const LAS float* lgp = plg + 512 * j + 8 * F.lane; const LAS float* lbp = plb + 512 * j + 8 * F.lane;
            const f32x4 lg0 = *(const LAS f32x4*)lgp, lg1 = *(const LAS f32x4*)(lgp + 4), lb0 = *(const LAS f32x4*)lbp, lb1 = *(const LAS f32x4*)(lbp + 4);
            *(f32x4*)(orow + 512 * j) = (f32x4){acc[j][0], acc[j][1], acc[j][2], acc[j][3]} * rstd * lg0 + lb0;
            *(f32x4*)(orow + 512 * j + 4) = (f32x4){acc[j][4], acc[j][5], acc[j][6], acc[j][7]} * rstd * lg1 + lb1; }
    }
}

__device__ __forceinline__ int opaque(int x) { asm volatile("" : "+v"(x)); return x; }
#define PHASE_FRAME(P) Frame P = F; P.lane = opaque(F.lane); P.tid = opaque(F.tid);
struct Args { const float* in[24]; float* out; unsigned char* ws; int ph_lo, ph_hi, li, pad; };
__global__ void __launch_bounds__(NWAVES * 64, 2) hymba_fwd(Args args) {
    extern __shared__ __attribute__((aligned(16))) unsigned char lds[];
    Frame F;
    F.lds = (LAS unsigned char*)lds;
    F.MISC = (volatile LAS unsigned*)(F.lds + MISC_OFF);
    F.tid = threadIdx.x; F.lane = F.tid & 63; F.wave = __builtin_amdgcn_readfirstlane(F.tid >> 6);
    F.G = gridDim.x; { const int bx = blockIdx.x; F.vcu = (F.G % 8 == 0) ? (bx % 8) * (F.G / 8) + bx / 8 : bx; }
    F.ws = args.ws; F.ctl = (unsigned*)(args.ws + WS_CTL); F.out = args.out;
#pragma unroll
    for (int i = 0; i < 24; ++i) F.in[i] = args.in[i];
    for (int u = F.tid; u < (LDS_BYTES - LDSCTL_OFF) / 4; u += NWAVES * 64) ((LAS unsigned*)(F.lds + LDSCTL_OFF))[u] = 0u;
    __syncthreads();
    const int lo = args.ph_lo, hi = args.ph_hi;
    XcdBarrier bar; bar.bar = F.ctl + CW_BAR + args.li * XCD_BAR_WORDS; bar.x = 0; bar.st = nullptr;
    if (hi - lo > 1) bar = xcd_barrier_post(F.ctl + CW_BAR + args.li * XCD_BAR_WORDS, F.MISC + 8);
#ifndef PHASE_MASK
#define PHASE_MASK 0x7ff
#endif
#define IN(k) ((((PHASE_MASK) >> (k)) & 1) && lo <= (k) && (k) < hi)
#define SEAM(k) do { if (IN(k) && IN((k) + 1)) xcd_barrier(bar); } while (0)
#ifndef PROBE_DUP
#define PROBE_DUP 0
#endif
#define REPS(k) for (int rep_ = 0; rep_ < (((PROBE_DUP) >> (k)) & 1) + 1; ++rep_)
#define REPBAR() do { if (rep_) xcd_barrier(bar); } while (0)

        if (IN(0)) {
        PHASE_FRAME(P) constexpr int NP0 = 64; const int nb0 = F.G >= 2 * NP0 ? NP0 : F.G;
        if ((int)blockIdx.x < nb0) { p0_mod(P, (int)blockIdx.x, nb0); p0_poolw(P, (int)blockIdx.x, nb0); }
        p0_convert(P, CW_Q0);
        if (PROBE_DUP & 1) { xcd_barrier(bar); if ((int)blockIdx.x < nb0) { p0_mod(P, (int)blockIdx.x, nb0); p0_poolw(P, (int)blockIdx.x, nb0); } p0_convert(P, CW_Q0 + 64); } } SEAM(0);
    if (IN(1)) REPS(1) { REPBAR(); PHASE_FRAME(P) p1_modulate(P); } SEAM(1);
    if (IN(2)) REPS(2) { REPBAR();
        pg8::Gemm g{(const bf16*)(F.ws + WS_H), (const bf16*)(F.ws + WS_WIN), D, 0, nullptr}; pg8::DenseOrder S; S.init(T, NPROJ, F.G, (int)blockIdx.x);
        pg8::EpiBf16 E{(bf16*)(F.ws + WS_PROJ), NPROJ, nullptr, 0, 1.0f / W8_SCALE, false};
        pg8::gemm_phase<pg8::EpiBf16, pg8::DenseOrder, false, true>(F.lds, g, S, E);
    } SEAM(2);
    if (IN(3)) REPS(3) { REPBAR(); PHASE_FRAME(P) p3_pool_filter(P); if (PROBE_SUB & 4) p3_pool_filter(P); p3_gla_prep(P); if (PROBE_SUB & 8) p3_gla_prep(P); } SEAM(3);
    if (IN(4)) REPS(4) { REPBAR(); PHASE_FRAME(P) p4_scan(P); } SEAM(4);
    if (IN(5)) REPS(5) { REPBAR(); PHASE_FRAME(P) p5_gla_out(P); } SEAM(5);
    if (IN(6)) REPS(6) { REPBAR();
        pg8::Gemm g{(const bf16*)(F.ws + WS_MIX), (const bf16*)(F.ws + WS_WOUT), D, 0, nullptr}; pg8::DenseOrder S; S.init(T, D, F.G, (int)blockIdx.x);
        pg8::EpiG1 E{(bf16*)(F.ws + WS_Z), (const float*)(F.ws + WS_MOD)};
        pg8::gemm_phase<pg8::EpiG1, pg8::DenseOrder, false, false>(F.lds, g, S, E);
    } SEAM(6);
    if (IN(7)) { PHASE_FRAME(P) p7_ln_router(P);
        if (PROBE_SUB & 16) { xcd_barrier(bar); if (blockIdx.x == 0 && F.tid < NE) __hip_atomic_store(F.ctl + CW_CNT + 64 * F.tid, 0u, RLX_AGENT); xcd_barrier(bar); p7_ln_router(P); } } SEAM(7);
    if (IN(8)) REPS(8) { REPBAR();
        build_ts(F);
        pg8::Gemm g{(const bf16*)(F.ws + WS_H), (const bf16*)(F.ws + WS_WGU), D, (size_t)2 * D * D, (const int*)(F.ws + WS_STOK)};
        const int bx = (int)blockIdx.x; const int grp = bx >> 6; const bool conv = (F.G == 256) && (((bx >> 3) & 7) == 0) && grp < NCONV8;
        const int widx = (F.G == 256) ? bx - 8 * (grp + 1 < NCONV8 ? grp + 1 : NCONV8) : bx, nwork = (F.G == 256) ? 256 - 8 * NCONV8 : F.G;
        if (!conv) {
        pg8::GroupOrder S; S.init((const LAS int*)(F.lds + TS_OFF), 16, nwork, widx);
        pg8::EpiSwiglu E{(unsigned char*)(F.ws + WS_ACT), F.in[17], F.in[19]};
        pg8::gemm_phase<pg8::EpiSwiglu, pg8::GroupOrder, true, true>(F.lds, g, S, E);
        }
        expert_queue(F, CW_Q0 + 128 + 64 * rep_, 2, 3);
    } SEAM(8);
    if (IN(9)) REPS(9) { REPBAR();
        build_ts(F);
        pg8::Gemm g{(const bf16*)(F.ws + WS_ACT), (const bf16*)(F.ws + WS_WDN), D, (size_t)D * D, nullptr};
        pg8::GroupOrder S; S.init((const LAS int*)(F.lds + TS_OFF), 8, F.G, (int)blockIdx.x, 0);
        pg8::EpiBf16 E{(bf16*)(F.ws + WS_Y), D, F.in[21], D, 1.0f / (W8_SCALE * ACT8_SCALE), false};
        pg8::gemm_phase<pg8::EpiBf16, pg8::GroupOrder, false, true>(F.lds, g, S, E);
    } SEAM(9);
    if (IN(10)) REPS(10) { REPBAR(); PHASE_FRAME(P) p10_final(P); }
#undef IN
#undef SEAM
}

extern "C" void kernel_launch(void* const* d_in, const int* in_sizes, int n_in, void* d_out, int out_size, void* d_ws, size_t ws_size, hipStream_t stream) {
    static int grid = 0;
    if (grid == 0) {
        if (n_in != 24 || in_sizes[0] != T * D || out_size != T * D || ws_size < WS_END) { fprintf(stderr, "kernel_launch: unexpected shapes / workspace (n_in %d, ws %zu); nothing launched\n", n_in, ws_size); grid = -1; return; }
        int dev = 0, cus = 0;
        if (hipGetDevice(&dev) != hipSuccess || hipDeviceGetAttribute(&cus, hipDeviceAttributeMultiprocessorCount, dev) != hipSuccess) { grid = -1; return; }
        if (hipFuncSetAttribute((const void*)hymba_fwd, hipFuncAttributeMaxDynamicSharedMemorySize, LDS_BYTES) != hipSuccess) { fprintf(stderr, "kernel_launch: hipFuncSetAttribute failed\n"); grid = -1; return; }
        int per_cu = 0;
        if (hipOccupancyMaxActiveBlocksPerMultiprocessor(&per_cu, (const void*)hymba_fwd, NWAVES * 64, LDS_BYTES) != hipSuccess || per_cu < 1) fprintf(stderr, "kernel_launch: note: occupancy query reports %d\n", per_cu);
        (void)hipGetLastError();
        grid = cus;
    }
    if (grid < 0) return;
    if (hipMemsetAsync((char*)d_ws + WS_CTL, 0, ZERO_BYTES, stream) != hipSuccess) return;
    Args a{};
    for (int i = 0; i < 24; ++i) a.in[i] = (const float*)d_in[i];
    a.out = (float*)d_out; a.ws = (unsigned char*)d_ws; a.pad = 0;
    constexpr int NL = MK_N_LAUNCHES;
    for (int li = 0; li < NL; ++li) {
        a.ph_lo = (NL == 1) ? 0 : li; a.ph_hi = (NL == 1) ? NPH : li + 1; a.li = 0;
        hipLaunchKernelGGL(hymba_fwd, dim3(grid), dim3(NWAVES * 64), LDS_BYTES, stream, a);
        const hipError_t le = hipPeekAtLastError();
        if (le != hipSuccess) { fprintf(stderr, "kernel_launch: launch %d failed: %s\n", li, hipGetErrorName(le)); break; }
    }
}
```

```cpp
#include <hip/hip_runtime.h>
#include <cstdio>
#include <cstdint>

#ifndef MK_N_LAUNCHES
#define MK_N_LAUNCHES 1
#endif

#ifndef PROBE_SUB
#define PROBE_SUB 0
#endif
#define GAS __attribute__((address_space(1)))
#define LAS __attribute__((address_space(3)))
typedef unsigned short bf16;
typedef unsigned v4u __attribute__((ext_vector_type(4)));
typedef unsigned v2u __attribute__((ext_vector_type(2)));
typedef float f32x4 __attribute__((ext_vector_type(4)));
typedef float f32x2 __attribute__((ext_vector_type(2)));
typedef short bf16x8 __attribute__((ext_vector_type(8)));
typedef int i32x8 __attribute__((ext_vector_type(8)));
typedef GAS unsigned gu32;
#define RLX_AGENT __ATOMIC_RELAXED, __HIP_MEMORY_SCOPE_AGENT
#define LDS_WAIT() asm volatile("s_waitcnt lgkmcnt(0)" ::: "memory")
#define VM_WAIT() asm volatile("s_waitcnt vmcnt(0)" ::: "memory")

constexpr int NB = 4, SEQ = 4096, D = 2048, T = NB * SEQ;
constexpr int INW = 4112;
constexpr int NPROJ = 4096;
constexpr int C_U = 0, C_Q = 1024, C_K = 1536, C_V = 2048, C_G = 3072;
constexpr int NE = 32, ECAP = 16384;
constexpr int NSLOT = 65536 + NE * 256;
constexpr float LN_EPS = 1e-5f, ALPHA = 1.189207115002721f;
constexpr int NWAVES = 8;
constexpr int NPH = 11;
constexpr int NCONV8 = 3;

constexpr size_t MiB = 1u << 20;
constexpr size_t WS_CTL = 0, WS_STOK = 1 * MiB, ZERO_BYTES = 3 * MiB;
constexpr size_t WS_MOD = 3 * MiB, WS_GK = 4 * MiB, WS_TOPE = 5 * MiB, WS_TOPW = WS_TOPE + 256 * 1024, WS_RANK = WS_TOPW + 256 * 1024;
constexpr size_t WS_WRT = WS_RANK + 256 * 1024;
constexpr size_t WS_WGT = 7 * MiB;
constexpr size_t WS_DEC = 6 * MiB, WS_WPOOL = 7 * MiB, WS_WOUT = 8 * MiB, WS_WIN = 16 * MiB, WS_WGU = 32 * MiB, WS_WDN = 544 * MiB;
constexpr size_t WS_X1 = 800 * MiB, WS_H = 928 * MiB, WS_PROJ = 992 * MiB, WS_MIX = 1120 * MiB, WS_SLOC = 1184 * MiB, WS_ST = 1312 * MiB, WS_Z = 1376 * MiB;
constexpr size_t WS_KHT = WS_SLOC, WS_VT = WS_SLOC + 16 * MiB, WS_QKH = WS_SLOC + 48 * MiB, WS_VT5 = WS_SLOC + 80 * MiB;
constexpr size_t WS_ACT = 992 * MiB;
constexpr size_t WS_Y = 1504 * MiB, WS_END = 1792 * MiB;
static_assert(WS_ACT + (size_t)NSLOT * D <= WS_ST && WS_Y + (size_t)NSLOT * D * 2 <= WS_END, "ws map");
constexpr int CW_TMO = 0;
constexpr int CW_CNT = 1024;
constexpr int CW_Q0 = 3072;
constexpr int CW_BAR = 4096;

constexpr int RING_BYTES = 131072;
constexpr int LDS_BYTES = 163840;
constexpr int LDSCTL_OFF = LDS_BYTES - 2048, TS_OFF = LDSCTL_OFF + 512, MISC_OFF = LDSCTL_OFF + 1024;

__device__ __forceinline__ unsigned f2bf(float f) { unsigned u = __builtin_bit_cast(unsigned, f); return (u + 0x7fffu + ((u >> 16) & 1u)) >> 16; }
__device__ __forceinline__ unsigned pk2(float lo, float hi) { return f2bf(lo) | (f2bf(hi) << 16); }
__device__ __forceinline__ float bflo(unsigned w) { return __builtin_bit_cast(float, w << 16); }
__device__ __forceinline__ float bfhi(unsigned w) { return __builtin_bit_cast(float, w & 0xffff0000u); }
__device__ __forceinline__ float bf2f(bf16 b) { return __builtin_bit_cast(float, ((unsigned)b) << 16); }
template <int CTRL> __device__ __forceinline__ float dpp_mov(float v) { return __builtin_bit_cast(float, __builtin_amdgcn_update_dpp(0, __builtin_bit_cast(int, v), CTRL, 0xf, 0xf, true)); }
__device__ __forceinline__ float rdlane(float v, int l) { return __builtin_bit_cast(float, __builtin_amdgcn_readlane(__builtin_bit_cast(int, v), l)); }
__device__ __forceinline__ float wave_sum(float v) {
    v += dpp_mov<0xB1>(v); v += dpp_mov<0x4E>(v); v += dpp_mov<0x141>(v); v += dpp_mov<0x140>(v);
    return (rdlane(v, 0) + rdlane(v, 16)) + (rdlane(v, 32) + rdlane(v, 48));
}
__device__ __forceinline__ unsigned pk4_fp8(float a, float b, float c, float d) { int w = 0; w = __builtin_amdgcn_cvt_pk_fp8_f32(a, b, w, false); w = __builtin_amdgcn_cvt_pk_fp8_f32(c, d, w, true); return (unsigned)w; }
constexpr float W8_SCALE = 64.0f, ACT8_SCALE = 4.0f;
template <class V> __device__ __forceinline__ V ldg(const void* ubase, unsigned off) { return *(const V*)((const char*)ubase + off); }
template <class V> __device__ __forceinline__ void stg(void* ubase, unsigned off, V v) { *(V*)((char*)ubase + off) = v; }
__device__ __forceinline__ f32x4 mma16(bf16x8 a, bf16x8 b, f32x4 c) { return __builtin_amdgcn_mfma_f32_16x16x32_bf16(a, b, c, 0, 0, 0); }

#ifndef KROT
#define KROT 1
#endif
namespace pg8 {
#define PG8_LAS __attribute__((address_space(3)))
typedef unsigned short bf16_t;
typedef unsigned u32x4 __attribute__((ext_vector_type(4)));
typedef int i32x4_t __attribute__((ext_vector_type(4)));
constexpr int BM = 256, BK = 64, HALF = 128, HTB = HALF * BK * 2, STAGE_BYTES = 8 * HTB, NXCD = 8, WGM = 4;

__host__ __device__ __forceinline__ int lds_byte(int r, int c) { const int st = (r >> 4) * 2 + (c >> 5), rr = r & 15, cc = c & 31, ob = rr * 64 + cc * 2; return st * 1024 + (ob ^ (((ob >> 9) & 1) << 5)); }
__host__ __device__ __forceinline__ void stage_rc(int b, int& R, int& C) { const int st = b / 1024, sb = b % 1024, swz = sb ^ (((sb >> 9) & 1) << 5); R = (st >> 1) * 16 + swz / 64; C = (st & 1) * 32 + (swz % 64) / 2; }
__host__ __device__ __forceinline__ int perm32(int rho) { const int n = rho >> 4, i = rho & 15; return 8 * (i >> 2) + 4 * n + (i & 3); }

struct Unit { int pm, pn, e, gm; };
struct Gemm { const bf16_t* A; const bf16_t* Bt; int K; size_t bstride; const int* rowidx; };

struct DenseOrder {
    int nM, nN, nwg, G, c;
    __device__ void init(int M, int N, int G_, int c_) { nM = M / BM; nN = N / BM; nwg = nM * nN; G = G_; c = c_; }
    __device__ __forceinline__ bool next(int i, Unit& u, int) const {
        const long L = (long)i * G + c; if (L >= nwg) return false;
        int wgid = (int)L; { const int q = nwg / NXCD, r = nwg % NXCD, xcd = wgid % NXCD, off = wgid / NXCD; wgid = (xcd < r ? xcd * (q + 1) : r * (q + 1) + (xcd - r) * q) + off; }
        const int nig = WGM * nN, gid = wgid / nig, fm = gid * WGM, gsz = (nM - fm) < WGM ? (nM - fm) : WGM;
        u.pm = fm + ((wgid % nig) % gsz); u.pn = (wgid % nig) / gsz; u.e = 0; u.gm = 0; return true;
    }
};
struct GroupOrder {
    const PG8_LAS int* ts; int nN, G, c, total, xr;
    __device__ void init(const PG8_LAS int* ts_, int nN_, int G_, int c_, int xr_ = 0) { ts = ts_; nN = nN_; G = G_; c = c_; xr = xr_; total = __builtin_amdgcn_readfirstlane(ts_[32]) * nN_; }
    __device__ __forceinline__ bool next(int i, Unit& u, int e0) const {
        int mt;
        if (xr) { const int k = c >> 3; mt = 4 * (i * 8 + (c & 7)) + (k >> 3); u.pn = k & 7; if (mt * nN >= total) return false; }
        else { const long L = (long)i * G + c; if (L >= total) return false; mt = (int)(L / nN); u.pn = (int)(L % nN); }
        int e = e0;
#pragma unroll 1
        while (e < 31 && ts[e + 1] <= mt) ++e;
        e = __builtin_amdgcn_readfirstlane(e); const int t0 = __builtin_amdgcn_readfirstlane(ts[e]);
        u.pm = mt; u.e = e; u.gm = e * (ECAP / 256) + (mt - t0); return true;
    }
};

__device__ __forceinline__ unsigned cvt_pk_bf16(float lo, float hi) { unsigned r; asm volatile("v_cvt_pk_bf16_f32 %0, %1, %2" : "=v"(r) : "v"(lo), "v"(hi)); return r; }

struct EpiBf16 {
    static constexpr bool PERM = true;
    bf16_t* O; int ldc; const float* bias; int bstride; float ascale; bool nt;
    __device__ __forceinline__ void operator()(const f32x4 (&acc)[2][2][4][2], const Unit& u, int wr, int wc, int fr, int fq) const {
        const int row0 = u.pm * BM + wr * 64 + fr; const int col0 = u.pn * BM + wc * 32 + 8 * fq;
        f32x4 bv[2][2];
#pragma unroll
        for (int bj = 0; bj < 2; ++bj)
#pragma unroll
            for (int n = 0; n < 2; ++n) bv[bj][n] = bias ? *(const f32x4*)(bias + (size_t)u.e * bstride + col0 + bj * HALF + 4 * n) : (f32x4){0.f, 0.f, 0.f, 0.f};
#pragma unroll
        for (int ai = 0; ai < 2; ++ai)
#pragma unroll
            for (int m = 0; m < 4; ++m) { bf16_t* rowp = O + (size_t)(row0 + ai * HALF + m * 16) * ldc + col0;
#pragma unroll
                for (int bj = 0; bj < 2; ++bj) { const f32x4 v0 = acc[ai][bj][m][0] * ascale + bv[bj][0], v1 = acc[ai][bj][m][1] * ascale + bv[bj][1];
                    u32x4 w; w.x = cvt_pk_bf16(v0[0], v0[1]); w.y = cvt_pk_bf16(v0[2], v0[3]); w.z = cvt_pk_bf16(v1[0], v1[1]); w.w = cvt_pk_bf16(v1[2], v1[3]);
                    if (nt) __builtin_nontemporal_store(w, (u32x4*)(rowp + bj * HALF)); else *(u32x4*)(rowp + bj * HALF) = w; } }
    }
};
__device__ __forceinline__ float swiglu1(float g, float u) {
    g = fminf(g, 7.0f); u = __builtin_amdgcn_fmed3f(u, -7.0f, 7.0f);
    const float e = __builtin_amdgcn_exp2f(g * -2.4554669595930157f);
    const float gs = g * __builtin_amdgcn_rcpf(e * (1.0f / ACT8_SCALE) + (1.0f / ACT8_SCALE));
    return gs * u + gs;
}
struct EpiSwiglu {
    static constexpr bool PERM = true;
    unsigned char* O; const float* bg; const float* bu;
    __device__ __forceinline__ void operator()(const f32x4 (&acc)[2][2][4][2], const Unit& u, int wr, int wc, int fr, int fq) const {
        const int row0 = u.pm * BM + wr * 64 + fr; const int col0 = u.pn * HALF + wc * 32 + 8 * fq; constexpr float is = 1.0f / W8_SCALE;
        f32x4 gv[2], uv[2];
#pragma unroll
        for (int n = 0; n < 2; ++n) { gv[n] = *(const f32x4*)(bg + (size_t)u.e * 2048 + col0 + 4 * n); uv[n] = *(const f32x4*)(bu + (size_t)u.e * 2048 + col0 + 4 * n); }
#pragma unroll
        for (int ai = 0; ai < 2; ++ai)
#pragma unroll
            for (int m = 0; m < 4; ++m) { unsigned char* rowp = O + (size_t)(row0 + ai * HALF + m * 16) * 2048 + col0;
                const f32x4 g0 = acc[ai][0][m][0] * is + gv[0], g1 = acc[ai][0][m][1] * is + gv[1], u0 = acc[ai][1][m][0] * is + uv[0], u1 = acc[ai][1][m][1] * is + uv[1];
                v2u w; w.x = pk4_fp8(swiglu1(g0[0], u0[0]), swiglu1(g0[1], u0[1]), swiglu1(g0[2], u0[2]), swiglu1(g0[3], u0[3]));
                w.y = pk4_fp8(swiglu1(g1[0], u1[0]), swiglu1(g1[1], u1[1]), swiglu1(g1[2], u1[2]), swiglu1(g1[3], u1[3]));
                *(v2u*)rowp = w; }
    }
};
struct EpiG1 {
    static constexpr bool PERM = true;
    bf16_t* O; const float* mod;
    __device__ __forceinline__ void operator()(const f32x4 (&acc)[2][2][4][2], const Unit& u, int wr, int wc, int fr, int fq) const {
        const int row0 = u.pm * BM + wr * 64 + fr, col0 = u.pn * BM + wc * 32 + 8 * fq; const int b = u.pm >> 4;
        f32x4 gv[2][2];
#pragma unroll
        for (int bj = 0; bj < 2; ++bj)
#pragma unroll
            for (int n = 0; n < 2; ++n) gv[bj][n] = *(const f32x4*)(mod + (size_t)b * 12288 + 4096 + col0 + bj * HALF + 4 * n);
#pragma unroll
        for (int ai = 0; ai < 2; ++ai)
#pragma unroll
            for (int m = 0; m < 4; ++m) { bf16_t* rowp = O + (size_t)(row0 + ai * HALF + m * 16) * 2048 + col0;
#pragma unroll
                for (int bj = 0; bj < 2; ++bj) { const f32x4 v0 = acc[ai][bj][m][0] * gv[bj][0], v1 = acc[ai][bj][m][1] * gv[bj][1];
                    u32x4 w; w.x = cvt_pk_bf16(v0[0], v0[1]); w.y = cvt_pk_bf16(v0[2], v0[3]); w.z = cvt_pk_bf16(v1[0], v1[1]); w.w = cvt_pk_bf16(v1[2], v1[3]);
                    *(u32x4*)(rowp + bj * HALF) = w; } }
    }
};
template <class Epi, class Sched, bool GATHER, bool FP8>
__device__ __forceinline__ void gemm_phase(PG8_LAS unsigned char* lds, const Gemm g, const Sched& S, const Epi& E) {
    const int tid = threadIdx.x, wid = __builtin_amdgcn_readfirstlane(tid >> 6), lane = tid & 63, wr = wid >> 2, wc = wid & 3, fr = lane & 15, fq = lane >> 4;
    const unsigned PITCH = FP8 ? (unsigned)g.K : 2u * (unsigned)g.K;
    const int nt = (int)(PITCH / 128u);
    const unsigned rot = KROT ? ((unsigned)blockIdx.x & 7u) * (unsigned)(nt >> 3) : 0u, ntm = (unsigned)(nt - 1);
#define PG8_KO(x) ((((unsigned)(x)) + rot & ntm) * kstep)
    int R0, C0, R1, C1; stage_rc(tid * 16, R0, C0); stage_rc(tid * 16 + 8192, R1, C1);
    const unsigned CB0 = 2u * (unsigned)C0, CB1 = 2u * (unsigned)C1;
    unsigned voffB0, voffB1;
    { const int Rb0 = Epi::PERM ? ((R0 & ~31) + perm32(R0 & 31)) : R0, Rb1 = Epi::PERM ? ((R1 & ~31) + perm32(R1 & 31)) : R1;
      voffB0 = (unsigned)Rb0 * PITCH + CB0; voffB1 = (unsigned)Rb1 * PITCH + CB1; }
    const unsigned kstep = 128u, hstep = (unsigned)HALF * PITCH, tstep = 2u * hstep;
    const unsigned ldsw = (unsigned)wid * 1024u;
    const int aoff = FP8 ? lds_byte(wr * 64 + fr, fq * 16) + 16 * (fq & 1) : lds_byte(wr * 64 + fr, fq * 8), boff = FP8 ? lds_byte(wc * 32 + fr, fq * 16) + 16 * (fq & 1) : lds_byte(wc * 32 + fr, fq * 8);
    const int aoffx = aoff ^ 16, boffx = boff ^ 16;
    const __amdgpu_buffer_rsrc_t srdA = __builtin_amdgcn_make_buffer_rsrc((void*)g.A, 0, 0x7fffffff, 0x00020000);
    const __amdgpu_buffer_rsrc_t srdB = __builtin_amdgcn_make_buffer_rsrc((void*)g.Bt, 0, 0x7fffffff, 0x00020000);
#define PG8_SA(b, h) (((b) * 2 + (h)) * HTB)
#define PG8_SB(b, h) ((4 + (b) * 2 + (h)) * HTB)
#define PG8_STAGEB(bufoff, so) do { \
        __builtin_amdgcn_raw_ptr_buffer_load_lds(srdB, (PG8_LAS unsigned*)(lds + (bufoff) + ldsw), 16, (int)voffB0, (int)(so), 0, 0); \
        __builtin_amdgcn_raw_ptr_buffer_load_lds(srdB, (PG8_LAS unsigned*)(lds + (bufoff) + ldsw + 8192), 16, (int)voffB1, (int)(so), 0, 0); } while (0)
#define PG8_STAGEA(bufoff, so, o0, o1) do { \
        __builtin_amdgcn_raw_ptr_buffer_load_lds(srdA, (PG8_LAS unsigned*)(lds + (bufoff) + ldsw), 16, (int)(o0), (int)(so), 0, 0); \
        __builtin_amdgcn_raw_ptr_buffer_load_lds(srdA, (PG8_LAS unsigned*)(lds + (bufoff) + ldsw + 8192), 16, (int)(o1), (int)(so), 0, 0); } while (0)
#define PG8_LDA(dst, b, h) do { _Pragma("unroll") for (int m = 0; m < 4; ++m) _Pragma("unroll") for (int k = 0; k < 2; ++k) dst[m][k] = *(const PG8_LAS bf16x8*)(lds + PG8_SA(b, h) + (FP8 ? (k ? aoffx : aoff) + m * 2048 : aoff + m * 2048 + k * 1024)); } while (0)
#define PG8_LDB(dst, b, h) do { _Pragma("unroll") for (int n = 0; n < 2; ++n) _Pragma("unroll") for (int k = 0; k < 2; ++k) dst[n][k] = *(const PG8_LAS bf16x8*)(lds + PG8_SB(b, h) + (FP8 ? (k ? boffx : boff) + n * 2048 : boff + n * 2048 + k * 1024)); } while (0)
#define PG8_CAT(x) __builtin_shufflevector(__builtin_bit_cast(i32x4_t, x[0]), __builtin_bit_cast(i32x4_t, x[1]), 0, 1, 2, 3, 4, 5, 6, 7)
#define PG8_MMA(ai, bj, At, Bt) do { __builtin_amdgcn_s_setprio(1); \
        if constexpr (FP8) { _Pragma("unroll") for (int m = 0; m < 4; ++m) _Pragma("unroll") for (int n = 0; n < 2; ++n) \
            asm volatile("s_nop 1\n\tv_mfma_f32_16x16x128_f8f6f4 %0, %1, %2, %0" : "+v"(acc[ai][bj][m][n]) : "v"(PG8_CAT(Bt[n])), "v"(PG8_CAT(At[m]))); } \
        else { _Pragma("unroll") for (int m = 0; m < 4; ++m) _Pragma("unroll") for (int n = 0; n < 2; ++n) _Pragma("unroll") for (int k = 0; k < 2; ++k) \
            acc[ai][bj][m][n] = __builtin_amdgcn_mfma_f32_16x16x32_bf16(Bt[n][k], At[m][k], acc[ai][bj][m][n], 0, 0, 0); } \
        __builtin_amdgcn_s_setprio(0); } while (0)
#define PG8_WAIT_V(n) asm volatile("s_waitcnt vmcnt(" #n ")" ::: "memory")
#define PG8_WAIT_L(n) asm volatile("s_waitcnt lgkmcnt(" #n ")" ::: "memory")
#define PG8_BAR __builtin_amdgcn_s_barrier()
#define PG8_SCHED __builtin_amdgcn_sched_barrier(0)
#define PG8_ROWOFF(u, o00, o01, o10, o11) do { \
        if constexpr (GATHER) { const int* rp_ = g.rowidx + (size_t)(u).gm * BM; \
            o00 = (unsigned)rp_[R0] * PITCH + CB0; o01 = (unsigned)rp_[R1] * PITCH + CB1; \
            o10 = (unsigned)rp_[HALF + R0] * PITCH + CB0; o11 = (unsigned)rp_[HALF + R1] * PITCH + CB1; } \
        else { const unsigned rb_ = (unsigned)(u).pm * BM; \
            o00 = (rb_ + R0) * PITCH + CB0; o01 = (rb_ + R1) * PITCH + CB1; \
            o10 = (rb_ + HALF + R0) * PITCH + CB0; o11 = (rb_ + HALF + R1) * PITCH + CB1; } } while (0)
    Unit cur, nxt; int ui = 0;
    if (!S.next(0, cur, 0)) return;
    f32x4 acc[2][2][4][2];
#pragma unroll
    for (int a = 0; a < 2; ++a)
#pragma unroll
        for (int b = 0; b < 2; ++b)
#pragma unroll
            for (int m = 0; m < 4; ++m)
#pragma unroll
                for (int n = 0; n < 2; ++n) acc[a][b][m][n] = (f32x4){0.f, 0.f, 0.f, 0.f};
    bf16x8 At[4][2], B0[2][2], B1[2][2];
    unsigned c00, c01, c10, c11, n00, n01, n10, n11;
    PG8_ROWOFF(cur, c00, c01, c10, c11);
    n00 = c00; n01 = c01; n10 = c10; n11 = c11;
    unsigned cB = (unsigned)cur.e * (unsigned)g.bstride + (unsigned)cur.pn * tstep;
    PG8_STAGEB(PG8_SB(0, 0), cB + PG8_KO(0)); PG8_STAGEB(PG8_SB(0, 1), cB + hstep + PG8_KO(0)); PG8_STAGEA(PG8_SA(0, 0), PG8_KO(0), c00, c01); PG8_STAGEA(PG8_SA(0, 1), PG8_KO(0), c10, c11);
    if (wr == 1) PG8_BAR;
    PG8_WAIT_V(2); PG8_BAR;
    PG8_STAGEB(PG8_SB(1, 0), cB + PG8_KO(1)); PG8_STAGEA(PG8_SA(1, 0), PG8_KO(1), c00, c01); PG8_STAGEB(PG8_SB(1, 1), cB + hstep + PG8_KO(1));
    PG8_WAIT_V(6); PG8_BAR;
    for (;;) {
        const bool has_next = S.next(ui + 1, nxt, cur.e);
        const unsigned nB = has_next ? (unsigned)nxt.e * (unsigned)g.bstride + (unsigned)nxt.pn * tstep : cB;
        for (int t = 0; t < nt; t += 2) {
            const bool last = (t == nt - 2);
            if (last) { if (has_next) { PG8_ROWOFF(nxt, n00, n01, n10, n11); } else { n00 = c00; n01 = c01; n10 = c10; n11 = c11; } }
            const unsigned k1 = PG8_KO(t + 1);
            const unsigned k2 = PG8_KO(last ? 0 : t + 2), k3 = PG8_KO(last ? 1 : t + 3);
            const unsigned b2 = (last ? nB : cB) + k2, b3 = (last ? nB : cB) + k3;
            const unsigned s00 = last ? n00 : c00, s01 = last ? n01 : c01, s10 = last ? n10 : c10, s11 = last ? n11 : c11;
            PG8_LDB(B0, 0, 0); PG8_LDB(B1, 0, 1); PG8_SCHED; PG8_LDA(At, 0, 0); PG8_STAGEA(PG8_SA(1, 1), k1, c10, c11);
            PG8_WAIT_V(8); PG8_WAIT_L(0); PG8_BAR; PG8_MMA(0, 0, At, B0); PG8_MMA(0, 1, At, B1); PG8_BAR; PG8_SCHED;
            PG8_LDA(At, 0, 1); PG8_STAGEB(PG8_SB(0, 0), b2); PG8_STAGEB(PG8_SB(0, 1), b2 + hstep); PG8_STAGEA(PG8_SA(0, 0), k2, s00, s01);
            PG8_WAIT_V(8); PG8_WAIT_L(0); PG8_BAR; PG8_MMA(1, 0, At, B0); PG8_MMA(1, 1, At, B1); PG8_BAR; PG8_SCHED;
            PG8_LDB(B0, 1, 0); PG8_LDB(B1, 1, 1); PG8_SCHED; PG8_LDA(At, 1, 0); PG8_STAGEA(PG8_SA(0, 1), k2, s10, s11);
            PG8_WAIT_V(8); PG8_WAIT_L(0); PG8_BAR; PG8_MMA(0, 0, At, B0); PG8_MMA(0, 1, At, B1); PG8_BAR; PG8_SCHED;
            PG8_LDA(At, 1, 1); PG8_STAGEB(PG8_SB(1, 0), b3); PG8_STAGEB(PG8_SB(1, 1), b3 + hstep); PG8_STAGEA(PG8_SA(1, 0), k3, s00, s01);
            PG8_WAIT_V(8); PG8_WAIT_L(0); PG8_BAR; PG8_MMA(1, 0, At, B0); PG8_MMA(1, 1, At, B1); PG8_BAR; PG8_SCHED;
        }
        if (wr == 0) PG8_BAR;
        if constexpr (FP8) {
#pragma unroll
            for (int a = 0; a < 2; ++a)
#pragma unroll
                for (int b = 0; b < 2; ++b)
                    asm volatile("s_nop 15" : "+v"(acc[a][b][0][0]), "+v"(acc[a][b][0][1]), "+v"(acc[a][b][1][0]), "+v"(acc[a][b][1][1]), "+v"(acc[a][b][2][0]), "+v"(acc[a][b][2][1]), "+v"(acc[a][b][3][0]), "+v"(acc[a][b][3][1]));
        }
        E(acc, cur, wr, wc, fr, fq);
        if ((PROBE_SUB & 128) && FP8) E(acc, cur, wr, wc, fr, fq);
        if ((PROBE_SUB & 256) && !FP8) E(acc, cur, wr, wc, fr, fq);
        if (!has_next) break;
#pragma unroll
        for (int a = 0; a < 2; ++a)
#pragma unroll
            for (int b = 0; b < 2; ++b)
#pragma unroll
                for (int m = 0; m < 4; ++m)
#pragma unroll
                    for (int n = 0; n < 2; ++n) acc[a][b][m][n] = (f32x4){0.f, 0.f, 0.f, 0.f};
        cur = nxt; cB = nB; c00 = n00; c01 = n01; c10 = n10; c11 = n11; ++ui;
        if (wr == 1) PG8_BAR;
    }
    PG8_WAIT_V(0);
    PG8_BAR;
#undef PG8_KO
#undef PG8_SA
#undef PG8_SB
#undef PG8_STAGEB
#undef PG8_STAGEA
#undef PG8_LDA
#undef PG8_LDB
#undef PG8_MMA
#undef PG8_CAT
#undef PG8_WAIT_V
#undef PG8_WAIT_L
#undef PG8_BAR
#undef PG8_SCHED
#undef PG8_ROWOFF
}
}

#define XB_TMO      128
#define XB_XCNT(j)  (256  + 64 * (j))
#define XB_XSUB(j)  (1280 + 64 * (j))
#define XB_XGEN(j)  (2304 + 64 * (j))
#define XB_TOP      3328
#define XB_TOPGEN   3392
#define XCD_BAR_WORDS 3456
#define XB_SPIN_CAP (1u << 18)

__device__ __forceinline__ unsigned xb_ld(unsigned* p)              { return __hip_atomic_load(p, __ATOMIC_RELAXED, __HIP_MEMORY_SCOPE_AGENT); }
__device__ __forceinline__ unsigned xb_add(unsigned* p, unsigned v) { return __hip_atomic_fetch_add(p, v, __ATOMIC_RELAXED, __HIP_MEMORY_SCOPE_AGENT); }
__device__ __forceinline__ unsigned xb_xcc_id() { return (unsigned)__builtin_amdgcn_s_getreg((3 << 11) | 20) & 0xFu; }
#define XB_SPIN(cond, bar) do { unsigned _sp = 0; while (cond) { __builtin_amdgcn_s_sleep(1); \
    if ((++_sp & 255u) == 0u) { if (xb_ld(&(bar)[XB_TMO])) break; if (_sp > XB_SPIN_CAP) { atomicAdd(&(bar)[XB_TMO], 1u); break; } } } } while (0)

struct XcdBarrier { unsigned* bar; unsigned x; volatile LAS unsigned* st; };

__device__ __forceinline__ XcdBarrier xcd_barrier_post(unsigned* bar, volatile LAS unsigned* st) {
    XcdBarrier b; b.bar = bar; b.x = xb_xcc_id(); b.st = st;
    if (threadIdx.x == 0) (void)xb_add(&bar[XB_XCNT(b.x)], 1u);
    return b;
}
__device__ __forceinline__ void xcd_barrier_complete(unsigned* bar, unsigned x, unsigned& nloc, unsigned& nx) {
    const unsigned G = gridDim.x * gridDim.y * gridDim.z;
    unsigned sum, cnt, mine, sp = 0u;
    for (;;) {
        sum = 0u; cnt = 0u; mine = 0u;
#pragma unroll
        for (unsigned j = 0; j < 16; ++j) { const unsigned c = xb_ld(&bar[XB_XCNT(j)]); sum += c; cnt += (c > 0u) ? 1u : 0u; mine = (j == x) ? c : mine; }
        if (sum == G) break;
        __builtin_amdgcn_s_sleep(1);
        if ((++sp & 255u) == 0u) { if (xb_ld(&bar[XB_TMO])) break; if (sp > XB_SPIN_CAP) { atomicAdd(&bar[XB_TMO], 1u); break; } }
    }
    nloc = mine > 0u ? mine : 1u; nx = cnt > 0u ? cnt : 1u;
}
__device__ __forceinline__ void xcd_barrier(const XcdBarrier& b) {
    asm volatile("s_waitcnt vmcnt(0)" ::: "memory");
    __syncthreads();
    if (threadIdx.x == 0) {
        unsigned* bar = b.bar;
        __builtin_amdgcn_s_waitcnt(0);
        unsigned nloc = b.st[0], nx = b.st[1];
        if (nloc == 0u) { xcd_barrier_complete(bar, b.x, nloc, nx); b.st[0] = nloc; b.st[1] = nx; }
        const unsigned old = xb_add(&bar[XB_XSUB(b.x)], 1u);
        const unsigned gen = old / nloc;
        if (old + 1u == (gen + 1u) * nloc) {
            __builtin_amdgcn_fence(__ATOMIC_RELEASE, "agent");
            asm volatile("s_waitcnt vmcnt(0)" ::: "memory");
            const unsigned og = xb_add(&bar[XB_TOP], 1u);
            const unsigned tg = og / nx;
            if (og + 1u == (tg + 1u) * nx) xb_add(&bar[XB_TOPGEN], 1u);
            else XB_SPIN(xb_ld(&bar[XB_TOPGEN]) == tg, bar);
            __builtin_amdgcn_fence(__ATOMIC_ACQUIRE, "agent");
            xb_add(&bar[XB_XGEN(b.x)], 1u);
            asm volatile("s_waitcnt vmcnt(0)" ::: "memory");
        } else {
            XB_SPIN(xb_ld(&bar[XB_XGEN(b.x)]) == gen, bar);
            __builtin_amdgcn_fence(__ATOMIC_ACQUIRE, "agent");
            asm volatile("s_waitcnt vmcnt(0)" ::: "memory");
        }
    }
    __syncthreads();
}

struct Frame {
    LAS unsigned char* lds;
    volatile LAS unsigned* MISC;
    unsigned* ctl;
    int tid, lane, wave;
    int vcu, G;
    unsigned char* ws;
    const float* in[24];
    float* out;
};

__device__ __forceinline__ void p0_mod(Frame& F, int jb, int nb) {
    LAS float* sc = (LAS float*)F.lds;
    LAS float* part = (LAS float*)(F.lds + 32768);
    const float* c = F.in[1]; const float* w_ada = F.in[2]; const float* b_ada = F.in[3];
    float* MOD = (float*)(F.ws + WS_MOD);
    for (int i = F.tid; i < NB * D; i += NWAVES * 64) { const float v = c[i]; sc[i] = v / (1.0f + expf(-v)); }
    __syncthreads();
    for (int strip = jb; strip < 256; strip += nb) {
        const int col0 = strip * 48; const int kr = F.lane / 12, cq = F.lane % 12;
        f32x4 a0 = {0.f, 0.f, 0.f, 0.f}, a1 = a0, a2 = a0, a3 = a0;
        if (F.lane < 48) {
#pragma unroll 8
            for (int it = 0; it < 64; ++it) { const int k = F.wave * 256 + it * 4 + kr;
                const f32x4 wv = *(const f32x4*)(w_ada + (size_t)k * 12288 + col0 + 4 * cq);
                a0 += wv * sc[k]; a1 += wv * sc[2048 + k]; a2 += wv * sc[4096 + k]; a3 += wv * sc[6144 + k]; }
        }
        LAS f32x4* pp = (LAS f32x4*)(part + (F.wave * 64 + F.lane) * 16); pp[0] = a0; pp[1] = a1; pp[2] = a2; pp[3] = a3;
        __syncthreads();
        if (F.tid < 192) { const int b = F.tid / 48, col = F.tid % 48, q = col >> 2, i = col & 3; float s = b_ada[col0 + col];
            for (int w = 0; w < 8; ++w)
#pragma unroll
                for (int r = 0; r < 4; ++r) s += part[(w * 64 + r * 12 + q) * 16 + b * 4 + i];
            MOD[(size_t)b * 12288 + col0 + col] = s; }
        __syncthreads();
    }
}
__device__ __forceinline__ void tr_item(const float* src, int ldw, bf16* dst, int ldd, LAS float* scr, int lane) {
#pragma unroll 8
    for (int i = 0; i < 32; ++i) { const int kk = 2 * i + (lane >> 5); scr[kk * 33 + (lane & 31)] = src[(size_t)kk * ldw + (lane & 31)]; }
    LDS_WAIT(); asm volatile("" ::: "memory");
    const int c = lane & 7;
#pragma unroll
    for (int j = 0; j < 4; ++j) { const int n = (lane >> 3) + 8 * j; const LAS float* s = scr + (8 * c) * 33 + n;
        v4u o; o.x = pk2(s[0 * 33], s[1 * 33]); o.y = pk2(s[2 * 33], s[3 * 33]); o.z = pk2(s[4 * 33], s[5 * 33]); o.w = pk2(s[6 * 33], s[7 * 33]);
        *(v4u*)(dst + (size_t)n * ldd + 8 * c) = o; }
    LDS_WAIT(); asm volatile("" ::: "memory");
}
__device__ __forceinline__ void tr_item8(const float* src, int ldw, unsigned char* dst, int ldd, LAS unsigned char* tile, int lane) {
    const int c4 = lane & 15, r = lane >> 4;
#pragma unroll 1
    for (int hf = 0; hf < 2; ++hf) {
        f32x4 x[4][4];
#pragma unroll
        for (int q = 0; q < 4; ++q)
#pragma unroll
            for (int j = 0; j < 4; ++j) x[q][j] = __builtin_nontemporal_load((const f32x4*)(src + (size_t)(64 * hf + 16 * q + 4 * r + j) * ldw + 4 * c4));
#pragma unroll
        for (int q = 0; q < 4; ++q)
#pragma unroll
            for (int m = 0; m < 4; ++m) { const unsigned w = pk4_fp8(x[q][0][m] * W8_SCALE, x[q][1][m] * W8_SCALE, x[q][2][m] * W8_SCALE, x[q][3][m] * W8_SCALE);
                *(LAS unsigned*)(tile + (4 * c4 + m) * 128 + 16 * ((4 * hf + q) ^ (c4 & 7)) + 4 * r) = w; }
    }
    LDS_WAIT(); asm volatile("" ::: "memory");
#pragma unroll
    for (int it = 0; it < 8; ++it) { const int n = 8 * it + (lane >> 3), ch = lane & 7;
        const v4u v = *(const LAS v4u*)(tile + n * 128 + 16 * (ch ^ ((n >> 2) & 7)));
        __builtin_nontemporal_store(v, (v4u*)(dst + (size_t)n * ldd + 16 * ch)); }
    LDS_WAIT(); asm volatile("" ::: "memory");
}
__device__ __forceinline__ void p0_poolw(Frame& F, int jb, int nb) {
    LAS float* At = (LAS float*)F.lds;
    const float* w_in = F.in[4]; const float* w_pool = F.in[7]; const float* pscale = F.in[9]; unsigned char* WIN = F.ws + WS_WIN;
    for (int up = jb; up < 256; up += nb) {
        const int gq = up >> 6, k0 = 32 * (up & 63);
        for (int idx = F.tid; idx < 2048; idx += NWAVES * 64) { const int row = idx >> 6, c4 = idx & 63;
            *(LAS f32x4*)(At + row * 256 + 4 * c4) = *(const f32x4*)(w_in + (size_t)(k0 + row) * INW + gq * 256 + 4 * c4); }
        __syncthreads();
        const int half = F.tid >> 8, d = F.tid & 255; const LAS float* Ah = At + half * 4096; const float* wp = w_pool + (size_t)gq * 65536 + d;
        float acc[16];
#pragma unroll
        for (int r = 0; r < 16; ++r) acc[r] = 0.f;
#pragma unroll 2
        for (int c = 0; c < 256; c += 4) { const float w0 = wp[(c + 0) * 256], w1 = wp[(c + 1) * 256], w2 = wp[(c + 2) * 256], w3 = wp[(c + 3) * 256];
#pragma unroll
            for (int r = 0; r < 16; ++r) { const f32x4 a = *(const LAS f32x4*)(Ah + r * 256 + c); acc[r] += (a.x * w0 + a.y * w1) + (a.z * w2 + a.w * w3); } }
        const float sc = pscale[gq * 256 + d] * W8_SCALE; unsigned w[4];
#pragma unroll
        for (int i = 0; i < 4; ++i) w[i] = pk4_fp8(acc[4 * i] * sc, acc[4 * i + 1] * sc, acc[4 * i + 2] * sc, acc[4 * i + 3] * sc);
        unsigned char* dp = WIN + (size_t)(gq * 256 + d) * D + k0 + 16 * half;
        *(v4u*)dp = (v4u){w[0], w[1], w[2], w[3]};
        __syncthreads();
    }
}
__device__ __forceinline__ void expert_queue(Frame& F, int qword, int w0, int w1) {
    LAS float* scr = (LAS float*)(F.lds + F.wave * 16384);
    unsigned char* WGU = F.ws + WS_WGU; unsigned char* WDN = F.ws + WS_WDN;
    constexpr int I_E = 16 * 32 * 32, QCH = 4; const int NQ = (w1 - w0) * I_E; LAS int* qslot = (LAS int*)(F.lds + LDSCTL_OFF);
    for (;;) {
        __syncthreads();
        if (F.tid == 0) qslot[0] = (int)__hip_atomic_fetch_add(F.ctl + qword, (unsigned)(8 * QCH), RLX_AGENT);
        __syncthreads();
        const int base = __builtin_amdgcn_readfirstlane(qslot[0]);
        if (base >= NQ) break;
#pragma unroll 1
        for (int qi = 0; qi < QCH; ++qi) { const int r = base + F.wave + 8 * qi; if (r >= NQ) break;
          const int which = w0 + r / I_E; const int rr = r % I_E; const int e = rr / 512, q = rr % 512, kb = q / 32, nb = q % 32, n0 = 64 * nb;
          LAS unsigned char* tile = (LAS unsigned char*)scr;
          const size_t esrc = (size_t)e * D * D + (size_t)(128 * kb) * D + n0;
          if (which == 0)      tr_item8(F.in[16] + esrc, D, WGU + (size_t)e * 2 * D * D + (size_t)(256 * (n0 >> 7) + (n0 & 127)) * D + 128 * kb, D, tile, F.lane);
          else if (which == 1) tr_item8(F.in[18] + esrc, D, WGU + (size_t)e * 2 * D * D + (size_t)(256 * (n0 >> 7) + 128 + (n0 & 127)) * D + 128 * kb, D, tile, F.lane);
          else                 tr_item8(F.in[20] + esrc, D, WDN + (size_t)e * D * D + (size_t)n0 * D + 128 * kb, D, tile, F.lane); }
    }
}
__device__ __forceinline__ void p0_convert(Frame& F, int qword) {
    { const float* w_router = F.in[14]; float* WRT = (float*)(F.ws + WS_WRT);
      for (int idx = F.vcu * NWAVES * 64 + F.tid; idx < 2048 * 32; idx += F.G * NWAVES * 64) WRT[(idx & 31) * 2048 + (idx >> 5)] = w_router[idx];
      const float* w_in = F.in[4]; float* WGT = (float*)(F.ws + WS_WGT);
      for (int idx = F.vcu * NWAVES * 64 + F.tid; idx < 2048 * 16; idx += F.G * NWAVES * 64) WGT[(idx & 15) * 2048 + (idx >> 4)] = w_in[(size_t)(idx >> 4) * INW + 3072 + (idx & 15)]; }
    LAS float* scr = (LAS float*)(F.lds + F.wave * 16384);
    const int gw = F.vcu * NWAVES + F.wave, NGW = F.G * NWAVES;
    unsigned char* WIN = F.ws + WS_WIN; bf16* WOUT = (bf16*)(F.ws + WS_WOUT);
    constexpr int I_IN = 16 * 48, I_OUT = 32 * 64;
    constexpr int NSMALL = I_IN + I_OUT;
    for (int it = gw; it < NSMALL; it += NGW) {
        int r = it;
        if (r < I_IN) { const int kb = r / 48, nb = 16 + r % 48; const int scol = 64 * nb + (nb >= 48 ? 16 : 0);
            tr_item8(F.in[4] + (size_t)(128 * kb) * INW + scol, INW, WIN + (size_t)(64 * nb) * D + 128 * kb, D, (LAS unsigned char*)scr, F.lane); continue; } r -= I_IN;
        { const int kb = r / 64, nb = r % 64;
            tr_item(F.in[11] + (size_t)(64 * kb) * D + 32 * nb, D, WOUT + (size_t)(32 * nb) * D + 64 * kb, D, scr, F.lane); }
    }
    expert_queue(F, qword, 0, 2);
}

__device__ __forceinline__ void p1_modulate(Frame& F) {
    LAS float* wg = (LAS float*)F.lds;
    const float* w_in = F.in[4]; const float* x = F.in[0];
    const float* MOD = (const float*)(F.ws + WS_MOD); unsigned char* H = F.ws + WS_H; float* GK = (float*)(F.ws + WS_GK);
    { const f32x4* WGT = (const f32x4*)(F.ws + WS_WGT); for (int idx = F.tid; idx < 2048 * 4; idx += NWAVES * 64) ((LAS f32x4*)wg)[idx] = WGT[idx]; }
    __syncthreads();
    for (int blk = F.vcu; blk < T / 64; blk += F.G) {
        const int b = blk / 64;
        const float* sh = MOD + (size_t)b * 12288; const float* scl = sh + 2048;
        f32x4 shv[8], scv[8];
#pragma unroll
        for (int j = 0; j < 8; ++j) { shv[j] = *(const f32x4*)(sh + 256 * j + 4 * F.lane); scv[j] = *(const f32x4*)(scl + 256 * j + 4 * F.lane) + 1.0f; }
        f32x4 vn[8];
        { const f32x4* xr = (const f32x4*)(x + (size_t)(blk * 64 + F.wave) * D) + F.lane;
#pragma unroll
          for (int j = 0; j < 8; ++j) vn[j] = xr[64 * j]; }
#pragma unroll 1
        for (int rr = 0; rr < 8; ++rr) {
            const int m = blk * 64 + rr * 8 + F.wave;
            f32x4 v[8]; float s = 0.f;
#pragma unroll
            for (int j = 0; j < 8; ++j) { v[j] = vn[j]; s += (v[j].x + v[j].y) + (v[j].z + v[j].w); }
            if (rr < 7) { const f32x4* xr = (const f32x4*)(x + (size_t)(m + 8) * D) + F.lane;
#pragma unroll
                for (int j = 0; j < 8; ++j) vn[j] = xr[64 * j]; }
            const float mean = wave_sum(s) * (1.f / D); float s2 = 0.f;
#pragma unroll
            for (int j = 0; j < 8; ++j) { v[j] = v[j] - mean; s2 += (v[j].x * v[j].x + v[j].y * v[j].y) + (v[j].z * v[j].z + v[j].w * v[j].w); }
            const float rstd = 1.f / sqrtf(wave_sum(s2) * (1.f / D) + LN_EPS);
            unsigned* o4 = (unsigned*)(H + (size_t)m * D) + F.lane;
#pragma unroll
            for (int j = 0; j < 8; ++j) { v[j] = v[j] * rstd * scv[j] + shv[j]; o4[64 * j] = pk4_fp8(v[j].x, v[j].y, v[j].z, v[j].w); }
            float res = 0.f;
#pragma unroll 1
            for (int r = 0; r < 16; ++r) { float a = 0.f;
#pragma unroll
                for (int j = 0; j < 8; ++j) { const f32x4 w4 = *(const LAS f32x4*)(wg + r * 2048 + 256 * j + 4 * F.lane); a += (v[j].x * w4.x + v[j].y * w4.y) + (v[j].z * w4.z + v[j].w * w4.w); }
                a = wave_sum(a); if (F.lane == r) res = a; }
            if (F.lane < 16) GK[(size_t)m * 16 + F.lane] = res;
        }
    }
}

__device__ __forceinline__ void p3_pool_filter(Frame& F) {
    const bf16* PROJ = (const bf16*)(F.ws + WS_PROJ); bf16* MIX = (bf16*)(F.ws + WS_MIX); const float* b_pool = F.in[8]; const float* pscale = F.in[9];
    for (int tile = F.vcu; tile < T / 64; tile += F.G) {
        const int gq = F.wave & 3, rh = F.wave >> 2, c8 = F.lane & 31, sub = F.lane >> 5;
        const int w = 2 << gq, ch = gq * 256 + c8 * 8, t0 = tile * 64, pos0 = t0 % SEQ, i0 = rh * 32 + sub * 16;
        float bs[8], sm[8];
#pragma unroll
        for (int i = 0; i < 8; ++i) { bs[i] = b_pool[ch + i] * pscale[ch + i]; sm[i] = 0.f; }
        for (int j = 1; j < w; ++j) if (pos0 + i0 - j >= 0) { const v4u v = *(const v4u*)(PROJ + (size_t)(t0 + i0 - j) * NPROJ + ch);
            sm[0] += bflo(v.x); sm[1] += bfhi(v.x); sm[2] += bflo(v.y); sm[3] += bfhi(v.y); sm[4] += bflo(v.z); sm[5] += bfhi(v.z); sm[6] += bflo(v.w); sm[7] += bfhi(v.w); }
#pragma unroll 4
        for (int ii = 0; ii < 16; ++ii) { const int i = i0 + ii; const size_t row = (size_t)(t0 + i);
            const v4u v = *(const v4u*)(PROJ + row * NPROJ + ch);
            const float cu[8] = {bflo(v.x), bfhi(v.x), bflo(v.y), bfhi(v.y), bflo(v.z), bfhi(v.z), bflo(v.w), bfhi(v.w)};
            const int pc = pos0 + i + 1; const float inv = 1.0f / (float)(pc < w ? pc : w); float o[8];
#pragma unroll
            for (int k = 0; k < 8; ++k) { sm[k] += cu[k]; o[k] = sm[k] * inv - cu[k] + bs[k]; }
            *(v4u*)(MIX + row * D + ch) = (v4u){pk2(o[0], o[1]), pk2(o[2], o[3]), pk2(o[4], o[5]), pk2(o[6], o[7])};
            if (pos0 + i - w + 1 >= 0) { const v4u d = *(const v4u*)(PROJ + (row - w + 1) * NPROJ + ch);
                sm[0] -= bflo(d.x); sm[1] -= bfhi(d.x); sm[2] -= bflo(d.y); sm[3] -= bfhi(d.y); sm[4] -= bflo(d.z); sm[5] -= bfhi(d.z); sm[6] -= bflo(d.w); sm[7] -= bfhi(d.w); } }
    }
}
__device__ __forceinline__ void p3_gla_prep(Frame& F) {
    LAS float* glr = (LAS float*)F.lds;
    const bf16* PROJ = (const bf16*)(F.ws + WS_PROJ); bf16* QKH = (bf16*)(F.ws + WS_QKH); const float* GK = (const float*)(F.ws + WS_GK); const float* w_gk = F.in[5]; const float* b_gk = F.in[6];
    bf16* KHT = (bf16*)(F.ws + WS_KHT); bf16* VT = (bf16*)(F.ws + WS_VT); bf16* VT5 = (bf16*)(F.ws + WS_VT5); float* DEC = (float*)(F.ws + WS_DEC);
    for (int ug = F.vcu; ug < 256; ug += F.G) {
        for (int idx = F.tid; idx < 4096; idx += NWAVES * 64) { const int u = 4 * ug + (idx >> 10), bh = u >> 6, n = u & 63; const int t0 = (bh >> 2) * SEQ + n * 64; glr[idx] = GK[(size_t)t0 * 16 + (idx & 1023)]; }
        __syncthreads();
        const int ci = F.tid >> 7, u = 4 * ug + ci, bh = u >> 6, n = u & 63, h = bh & 3, t0 = (bh >> 2) * SEQ + n * 64;
        { const int d = F.tid & 127; float wk[16];
#pragma unroll
          for (int r = 0; r < 16; ++r) wk[r] = w_gk[r * 512 + h * 128 + d];
          const float bk = b_gk[h * 128 + d];
          const bf16* qp = PROJ + (size_t)t0 * NPROJ + C_Q + h * 128 + d; const bf16* kp = PROJ + (size_t)t0 * NPROJ + C_K + h * 128 + d;
          bf16* qo = QKH + (size_t)t0 * 1024 + h * 128 + d; bf16* ko = qo + 512;
          float run = 0.f; unsigned kpk[32];
#pragma unroll
          for (int tb = 0; tb < 64; tb += 16) { bf16 qv[16], kv[16];
#pragma unroll
              for (int i = 0; i < 16; ++i) { qv[i] = qp[(size_t)(tb + i) * NPROJ]; kv[i] = kp[(size_t)(tb + i) * NPROJ]; }
#pragma unroll
              for (int i = 0; i < 16; ++i) { const int t = tb + i; const LAS f32x4* gp = (const LAS f32x4*)(glr + ci * 1024 + t * 16);
                  const f32x4 g0 = gp[0], g1 = gp[1], g2 = gp[2], g3 = gp[3];
                  float xv = bk + ((g0.x * wk[0] + g0.y * wk[1]) + (g0.z * wk[2] + g0.w * wk[3])) + ((g1.x * wk[4] + g1.y * wk[5]) + (g1.z * wk[6] + g1.w * wk[7]))
                                + ((g2.x * wk[8] + g2.y * wk[9]) + (g2.z * wk[10] + g2.w * wk[11])) + ((g3.x * wk[12] + g3.y * wk[13]) + (g3.z * wk[14] + g3.w * wk[15]));
                  const float ls = fminf(xv, 0.f) - __logf(1.0f + __expf(-fabsf(xv)));
                  run += ls * (1.0f / 16.0f);
                  const float e = __expf(run), ei = __expf(-run);
                  const unsigned qh = f2bf(bf2f(qv[i]) * e * 0.08838834764831845f), kh = f2bf(bf2f(kv[i]) * ei);
                  qo[(size_t)t * 1024] = (bf16)qh; ko[(size_t)t * 1024] = (bf16)kh;
                  if (t & 1) kpk[t >> 1] |= kh << 16; else kpk[t >> 1] = kh; } }
          DEC[(size_t)u * 128 + d] = __expf(run);
#pragma unroll
          for (int i = 0; i < 8; ++i) { const int kk = i >> 2, q = i & 3;
              *(v4u*)(KHT + ((((size_t)u * 8 + (d >> 4)) * 2 + kk) * 64 + (d & 15) + 16 * q) * 8) = (v4u){kpk[16 * kk + 2 * q], kpk[16 * kk + 2 * q + 1], kpk[16 * kk + 8 + 2 * q], kpk[16 * kk + 9 + 2 * q]}; } }
        { const int dvp = F.tid & 127;
          const unsigned* vp = (const unsigned*)(PROJ + (size_t)t0 * NPROJ + C_V + h * 256 + 2 * dvp);
#pragma unroll 1
          for (int hb = 0; hb < 2; ++hb) { unsigned vv[32];
#pragma unroll
              for (int i = 0; i < 32; ++i) vv[i] = vp[(size_t)(hb * 32 + i) * (NPROJ / 2)];
              unsigned lo[16], hi[16];
#pragma unroll
              for (int i = 0; i < 16; ++i) { lo[i] = (vv[2 * i] & 0xffffu) | (vv[2 * i + 1] << 16); hi[i] = (vv[2 * i] >> 16) | (vv[2 * i + 1] & 0xffff0000u); }
              const int dv0 = 2 * dvp, dvt = dv0 >> 4;
#pragma unroll
              for (int q = 0; q < 4; ++q) { const size_t f0 = ((((size_t)u * 16 + dvt) * 2 + hb) * 64 + (dv0 & 15) + 16 * q) * 8;
                  *(v4u*)(VT5 + f0) = (v4u){lo[2 * q], lo[2 * q + 1], lo[8 + 2 * q], lo[8 + 2 * q + 1]}; *(v4u*)(VT5 + f0 + 8) = (v4u){hi[2 * q], hi[2 * q + 1], hi[8 + 2 * q], hi[8 + 2 * q + 1]}; } } }
        __syncthreads();
    }
}
__device__ __forceinline__ void p4_scan(Frame& F) {
    const bf16* KHT = (const bf16*)(F.ws + WS_KHT); const bf16* VT = (const bf16*)(F.ws + WS_VT5); const float* DEC = (const float*)(F.ws + WS_DEC); bf16* ST = (bf16*)(F.ws + WS_ST);
    const int l15 = F.lane & 15, lq = F.lane >> 4;
    if (F.wave < 4)
    for (int gw = F.vcu * 4 + F.wave; gw < 1024; gw += F.G * 4) {
        const int bh = gw >> 6, dvt = (gw >> 2) & 15, kp = gw & 3;
        const bf16* vt = VT + (((size_t)bh * 64 * 16 + dvt) * 2 * 64 + F.lane) * 8;
        const bf16* kt = KHT + (((size_t)bh * 64 * 8 + 2 * kp) * 2 * 64 + F.lane) * 8;
        const float* de = DEC + (size_t)bh * 64 * 128 + kp * 32 + 4 * lq;
        bf16* st = ST + (size_t)bh * 64 * 32768 + ((size_t)(dvt * 4 + kp) * 64 + F.lane) * 8;
        f32x4 S0 = {0.f, 0.f, 0.f, 0.f}, S1 = S0;
#pragma unroll 4
        for (int n = 0; n < 64; ++n) {
            const bf16x8 b0 = *(const bf16x8*)(vt + (size_t)n * 16384), b1 = *(const bf16x8*)(vt + (size_t)n * 16384 + 512);
            const bf16x8 a00 = *(const bf16x8*)(kt + (size_t)n * 8192), a01 = *(const bf16x8*)(kt + (size_t)n * 8192 + 512);
            const bf16x8 a10 = *(const bf16x8*)(kt + (size_t)n * 8192 + 1024), a11 = *(const bf16x8*)(kt + (size_t)n * 8192 + 1536);
            const f32x4 d0 = *(const f32x4*)(de + (size_t)n * 128), d1 = *(const f32x4*)(de + (size_t)n * 128 + 16);
            *(v4u*)(st + (size_t)n * 32768) = (v4u){pk2(S0[0], S0[1]), pk2(S0[2], S0[3]), pk2(S1[0], S1[1]), pk2(S1[2], S1[3])};
            S0 = mma16(a00, b0, S0); S0 = mma16(a01, b1, S0); S0 = S0 * d0;
            S1 = mma16(a10, b0, S1); S1 = mma16(a11, b1, S1); S1 = S1 * d1; }
    }
}
__device__ __forceinline__ void p5_gla_out(Frame& F) {
    const bf16* PROJ = (const bf16*)(F.ws + WS_PROJ); const bf16* QKH = (const bf16*)(F.ws + WS_QKH); const bf16* VT5 = (const bf16*)(F.ws + WS_VT5); const bf16* ST = (const bf16*)(F.ws + WS_ST); bf16* MIX = (bf16*)(F.ws + WS_MIX); const float* norm_w = F.in[10];
    const int l15 = F.lane & 15, lq = F.lane >> 4;
    for (int wu = F.vcu * NWAVES + F.wave; wu < 4096; wu += F.G * NWAVES) {
        const int u = wu >> 2, tt = wu & 3, bh = u >> 6, n = u & 63, h = bh & 3, t0 = (bh >> 2) * SEQ + n * 64;
        const size_t trow = (size_t)(t0 + 16 * tt + l15);
        bf16x8 qf[4];
#pragma unroll
        for (int kk = 0; kk < 4; ++kk) { const bf16* qp_ = QKH + trow * 1024 + h * 128 + 32 * kk + 4 * lq; const v2u qa = *(const v2u*)qp_, qb = *(const v2u*)(qp_ + 16);
            qf[kk] = __builtin_bit_cast(bf16x8, (v4u){qa.x, qa.y, qb.x, qb.y}); }
        unsigned pt[4][2];
#pragma unroll
        for (int st = 0; st < 4; ++st) { pt[st][0] = 0u; pt[st][1] = 0u;
            if (st <= tt) { f32x4 a = {0.f, 0.f, 0.f, 0.f};
#pragma unroll
                for (int kk = 0; kk < 4; ++kk) { const bf16* kp_ = QKH + (size_t)(t0 + 16 * st + l15) * 1024 + 512 + h * 128 + 32 * kk + 4 * lq; const v2u ka = *(const v2u*)kp_, kb2 = *(const v2u*)(kp_ + 16);
                    a = mma16(__builtin_bit_cast(bf16x8, (v4u){ka.x, ka.y, kb2.x, kb2.y}), qf[kk], a); }
                const int sb = 16 * st + 4 * lq, tq = 16 * tt + l15;
                pt[st][0] = pk2(sb + 0 <= tq ? a[0] : 0.f, sb + 1 <= tq ? a[1] : 0.f); pt[st][1] = pk2(sb + 2 <= tq ? a[2] : 0.f, sb + 3 <= tq ? a[3] : 0.f); } }
        const bf16x8 pf0 = __builtin_bit_cast(bf16x8, (v4u){pt[0][0], pt[0][1], pt[1][0], pt[1][1]}), pf1 = __builtin_bit_cast(bf16x8, (v4u){pt[2][0], pt[2][1], pt[3][0], pt[3][1]});
        f32x4 o[16];
        bf16x8 sfb[4][4]; v4u vfb[4][2];
#define P5_LOAD(buf, dvt_) do { const bf16* sp_ = ST + (size_t)u * 32768 + ((size_t)(dvt_) * 256 + F.lane) * 8; const bf16* vp_ = VT5 + (((size_t)u * 16 + (dvt_)) * 2 * 64 + F.lane) * 8; \
            _Pragma("unroll") for (int kk = 0; kk < 4; ++kk) sfb[buf][kk] = *(const bf16x8*)(sp_ + 512 * kk); \
            vfb[buf][0] = *(const v4u*)vp_; if (tt >= 2) vfb[buf][1] = *(const v4u*)(vp_ + 512); } while (0)
        P5_LOAD(0, 0); P5_LOAD(1, 1); P5_LOAD(2, 2);
#pragma unroll
        for (int dvt = 0; dvt < 16; ++dvt) { const int cb = dvt & 3;
            if (dvt + 3 < 16) P5_LOAD((dvt + 3) & 3, dvt + 3);
            f32x4 a = {0.f, 0.f, 0.f, 0.f};
#pragma unroll
            for (int kk = 0; kk < 4; ++kk) a = mma16(sfb[cb][kk], qf[kk], a);
            a = mma16(__builtin_bit_cast(bf16x8, vfb[cb][0]), pf0, a);
            if (tt >= 2) a = mma16(__builtin_bit_cast(bf16x8, vfb[cb][1]), pf1, a);
            o[dvt] = a; }
#undef P5_LOAD
        float ss = 0.f;
#pragma unroll
        for (int dvt = 0; dvt < 16; ++dvt) ss += (o[dvt][0] * o[dvt][0] + o[dvt][1] * o[dvt][1]) + (o[dvt][2] * o[dvt][2] + o[dvt][3] * o[dvt][3]);
        ss += __shfl_xor(ss, 16); ss += __shfl_xor(ss, 32);
        const float rinv = 1.0f / sqrtf(ss * (1.0f / 256.0f) + 1e-6f);
#pragma unroll
        for (int dvt = 0; dvt < 16; ++dvt) { const int dv0 = dvt * 16 + 4 * lq;
            const f32x4 nw = *(const f32x4*)(norm_w + dv0); const v2u gv = *(const v2u*)(PROJ + trow * NPROJ + C_G + h * 256 + dv0);
            const float g0 = bflo(gv.x), g1 = bfhi(gv.x), g2 = bflo(gv.y), g3 = bfhi(gv.y);
            v2u w; w.x = pk2(o[dvt][0] * rinv * nw.x * g0 * __builtin_amdgcn_rcpf(1.0f + __expf(-g0)), o[dvt][1] * rinv * nw.y * g1 * __builtin_amdgcn_rcpf(1.0f + __expf(-g1)));
            w.y = pk2(o[dvt][2] * rinv * nw.z * g2 * __builtin_amdgcn_rcpf(1.0f + __expf(-g2)), o[dvt][3] * rinv * nw.w * g3 * __builtin_amdgcn_rcpf(1.0f + __expf(-g3)));
            *(v2u*)(MIX + trow * D + 1024 + h * 256 + dv0) = w; }
    }
}

constexpr int HS_LD = 2052;
constexpr int L7_HS = 0, L7_PART = 131584, L7_RED = 147968, L7_AE = 150016, L7_AW = 151040, L7_WC = 152064, L7_EB = 153088;
__device__ __forceinline__ void p7_ln_router(Frame& F) {
    LAS float* hs = (LAS float*)(F.lds + L7_HS); LAS float* part = (LAS float*)(F.lds + L7_PART); LAS float* red = (LAS float*)(F.lds + L7_RED);
    LAS int* ae = (LAS int*)(F.lds + L7_AE); LAS float* aw = (LAS float*)(F.lds + L7_AW); LAS int* wcn = (LAS int*)(F.lds + L7_WC); LAS int* eb = (LAS int*)(F.lds + L7_EB);
    const bf16* YG = (const bf16*)(F.ws + WS_Z); const float* X = F.in[0]; bf16* X1B = (bf16*)(F.ws + WS_X1); unsigned char* H2 = F.ws + WS_H;
    const float* MOD = (const float*)(F.ws + WS_MOD); const float* WRT = (const float*)(F.ws + WS_WRT); const float* b_router = F.in[15];
    int* TOPE = (int*)(F.ws + WS_TOPE); float* TOPW = (float*)(F.ws + WS_TOPW); int* RANK = (int*)(F.ws + WS_RANK); int* STOK = (int*)(F.ws + WS_STOK);
    const int l15 = F.lane & 15, lq = F.lane >> 4;
    const int col = 256 * F.wave + 4 * F.lane;
    const f32x4 lng = *(const f32x4*)(F.in[12] + col), lnb = *(const f32x4*)(F.in[13] + col);
#define P7_STATS(which, ps1, ps2, meanv, rstdv) do { \
        _Pragma("unroll") for (int r = 0; r < 16; ++r) { const float t1 = wave_sum(ps1[r]), t2 = wave_sum(ps2[r]); if (F.lane == 0) { red[((which) * 2 + 0) * 128 + F.wave * 16 + r] = t1; red[((which) * 2 + 1) * 128 + F.wave * 16 + r] = t2; } } \
        __syncthreads(); \
        { float a1 = 0.f, a2 = 0.f; if (F.lane < 16) { _Pragma("unroll") for (int w = 0; w < 8; ++w) { a1 += red[((which) * 2 + 0) * 128 + w * 16 + F.lane]; a2 += red[((which) * 2 + 1) * 128 + w * 16 + F.lane]; } } \
          meanv = a1 * (1.f / D); rstdv = 1.f / sqrtf(fmaxf(a2 * (1.f / D) - meanv * meanv, 0.f) + LN_EPS); } } while (0)
    for (int blk = F.vcu; blk < T / 64; blk += F.G) {
        const int b = blk / 64; const f32x4 sh2 = *(const f32x4*)(MOD + (size_t)b * 12288 + 3 * 2048 + col), sc2 = *(const f32x4*)(MOD + (size_t)b * 12288 + 4 * 2048 + col) + 1.0f;
#pragma unroll 1
        for (int sb = 0; sb < 4; ++sb) {
            const int m0 = blk * 64 + sb * 16;
            f32x4 z[16]; float ps1[16], ps2[16];
            { f32x4 xv[16]; v2u yv[16];
#pragma unroll
              for (int r = 0; r < 16; ++r) { xv[r] = *(const f32x4*)(X + (size_t)(m0 + r) * D + col); yv[r] = *(const v2u*)(YG + (size_t)(m0 + r) * D + col); }
#pragma unroll
              for (int r = 0; r < 16; ++r) { z[r] = xv[r] * ALPHA + (f32x4){bflo(yv[r].x), bfhi(yv[r].x), bflo(yv[r].y), bfhi(yv[r].y)};
                  ps1[r] = (z[r].x + z[r].y) + (z[r].z + z[r].w); ps2[r] = (z[r].x * z[r].x + z[r].y * z[r].y) + (z[r].z * z[r].z + z[r].w * z[r].w); } }
            float meanv, rstdv;
            P7_STATS(0, ps1, ps2, meanv, rstdv);
#pragma unroll
            for (int r = 0; r < 16; ++r) { const float mu = rdlane(meanv, r), rs = rdlane(rstdv, r);
                z[r] = (z[r] - mu) * rs * lng + lnb;
                *(v2u*)(X1B + (size_t)(m0 + r) * D + col) = (v2u){pk2(z[r].x, z[r].y), pk2(z[r].z, z[r].w)};
                ps1[r] = (z[r].x + z[r].y) + (z[r].z + z[r].w); ps2[r] = (z[r].x * z[r].x + z[r].y * z[r].y) + (z[r].z * z[r].z + z[r].w * z[r].w); }
            P7_STATS(1, ps1, ps2, meanv, rstdv);
#pragma unroll
            for (int r = 0; r < 16; ++r) { const float mu = rdlane(meanv, r), rs = rdlane(rstdv, r);
                const f32x4 h = (z[r] - mu) * rs * sc2 + sh2;
                *(unsigned*)(H2 + (size_t)(m0 + r) * D + col) = pk4_fp8(h.x, h.y, h.z, h.w);
                *(LAS f32x4*)(hs + r * HS_LD + col) = h; }
            asm volatile("s_waitcnt lgkmcnt(0)" ::: "memory");
            { f32x4 a0 = {0.f, 0.f, 0.f, 0.f}, a1 = a0;
#pragma unroll 8
              for (int kb = 0; kb < 16; ++kb) { const int k0 = 256 * F.wave + 16 * kb + 4 * lq;
                  const f32x4 af = *(const LAS f32x4*)(hs + l15 * HS_LD + k0);
                  const f32x4 b0 = ldg<f32x4>(WRT, ((unsigned)l15 * 2048u + (unsigned)k0) * 4u), b1 = ldg<f32x4>(WRT, ((unsigned)(16 + l15) * 2048u + (unsigned)k0) * 4u);
#pragma unroll
                  for (int sI = 0; sI < 4; ++sI) { a0 = __builtin_amdgcn_mfma_f32_16x16x4f32(af[sI], b0[sI], a0, 0, 0, 0); a1 = __builtin_amdgcn_mfma_f32_16x16x4f32(af[sI], b1[sI], a1, 0, 0, 0); } }
#pragma unroll
              for (int rg = 0; rg < 4; ++rg) { part[(F.wave * 16 + 4 * lq + rg) * 32 + l15] = a0[rg]; part[(F.wave * 16 + 4 * lq + rg) * 32 + 16 + l15] = a1[rg]; } }
            __syncthreads();
#pragma unroll 1
            for (int rr = 0; rr < 2; ++rr) { const int row = F.wave + 8 * rr;
              float lgv = -3.0e38f;
              if (F.lane < 32) { lgv = b_router[F.lane];
#pragma unroll
                  for (int w = 0; w < 8; ++w) lgv += part[(w * 16 + row) * 32 + F.lane]; }
              int cnt = 0;
#pragma unroll
              for (int e = 0; e < 32; ++e) { const float o = rdlane(lgv, e); cnt += (o > lgv || (o == lgv && e < F.lane)) ? 1 : 0; }
              float sv[4]; int si[4];
#pragma unroll
              for (int k = 0; k < 4; ++k) { const unsigned long long mk = __ballot(F.lane < 32 && cnt == k); si[k] = (int)__builtin_ctzll(mk); sv[k] = rdlane(lgv, si[k]); }
              const float e1 = expf(sv[1] - sv[0]), e2 = expf(sv[2] - sv[0]), e3 = expf(sv[3] - sv[0]); const float inv = 1.0f / (1.0f + e1 + e2 + e3);
              if (F.lane == 0) { const int base = (sb * 16 + row) * 4;
                  ae[base + 0] = si[0]; ae[base + 1] = si[1]; ae[base + 2] = si[2]; ae[base + 3] = si[3];
                  aw[base + 0] = inv; aw[base + 1] = e1 * inv; aw[base + 2] = e2 * inv; aw[base + 3] = e3 * inv; } }
            __syncthreads();
        }
        int myE = 0, lr = 0;
        if (F.wave < 4) { myE = ae[F.tid]; int wc = 0;
#pragma unroll
            for (int e = 0; e < 32; ++e) { const unsigned long long mk = __ballot(myE == e); if (myE == e) lr = __builtin_popcountll(mk & ((1ull << F.lane) - 1ull)); if (F.lane == e) wc = __builtin_popcountll(mk); }
            if (F.lane < 32) wcn[F.wave * 32 + F.lane] = wc; }
        __syncthreads();
        if (F.tid < 32) { const int c0 = wcn[F.tid], c1 = wcn[32 + F.tid], c2 = wcn[64 + F.tid], c3 = wcn[96 + F.tid], tot = c0 + c1 + c2 + c3;
            const int base = tot ? (int)__hip_atomic_fetch_add(F.ctl + CW_CNT + 64 * F.tid, (unsigned)tot, RLX_AGENT) : 0;
            eb[F.tid] = base; eb[32 + F.tid] = base + c0; eb[64 + F.tid] = base + c0 + c1; eb[96 + F.tid] = base + c0 + c1 + c2; }
        __syncthreads();
        if (F.wave < 4) { const int rk = eb[F.wave * 32 + myE] + lr, m = blk * 64 + (F.tid >> 2);
            TOPE[(size_t)blk * 256 + F.tid] = myE; TOPW[(size_t)blk * 256 + F.tid] = aw[F.tid]; RANK[(size_t)blk * 256 + F.tid] = rk;
            STOK[(size_t)myE * ECAP + rk] = m; }
        __syncthreads();
    }
#undef P7_STATS
}
__device__ __forceinline__ void build_ts(Frame& F) {
    LAS int* ts = (LAS int*)(F.lds + TS_OFF);
    if (F.tid < 64) {
        const unsigned c = (F.lane < NE) ? __hip_atomic_load(F.ctl + CW_CNT + 64 * (F.lane & 31), RLX_AGENT) : 0u;
        const int nt = (int)((c + 255u) >> 8); int inc = nt;
#pragma unroll
        for (int o = 1; o < 32; o <<= 1) { const int v = __shfl_up(inc, o); if (F.lane >= o) inc += v; }
        if (F.lane < NE) ts[F.lane] = inc - nt;
        if (F.lane == NE - 1) ts[NE] = inc;
    }
    __syncthreads();
}
__device__ __forceinline__ void p10_final(Frame& F) {
    build_ts(F);
    const LAS int* ts = (const LAS int*)(F.lds + TS_OFF);
    LAS float* pg2 = (LAS float*)F.lds; LAS float* plg = pg2 + 4 * 2048; LAS float* plb = plg + 2048;
    const bf16* X1B = (const bf16*)(F.ws + WS_X1); const bf16* Y = (const bf16*)(F.ws + WS_Y); const float* MOD = (const float*)(F.ws + WS_MOD);
    const int* TOPE = (const int*)(F.ws + WS_TOPE); const float* TOPW = (const float*)(F.ws + WS_TOPW); const int* RANK = (const int*)(F.ws + WS_RANK);
    for (int i = F.tid; i < 4 * 2048; i += NWAVES * 64) pg2[i] = MOD[(size_t)(i >> 11) * 12288 + 5 * 2048 + (i & 2047)];
    for (int i = F.tid; i < 2048; i += NWAVES * 64) { plg[i] = F.in[22][i]; plb[i] = F.in[23][i]; }
    __syncthreads();
    const int gw = F.vcu * NWAVES + F.wave, NGW = F.G * NWAVES;
    int4 e4n = {0, 0, 0, 0}, r4n = e4n; f32x4 w4n = {0.f, 0.f, 0.f, 0.f};
    if (gw < T) { e4n = *(const int4*)(TOPE + (size_t)gw * 4); r4n = *(const int4*)(RANK + (size_t)gw * 4); w4n = *(const f32x4*)(TOPW + (size_t)gw * 4); }
#pragma unroll 1
    for (int m = gw; m < T; m += NGW) {
        const int b = m / SEQ;
        const int4 e4 = e4n, r4 = r4n; const f32x4 w4 = w4n;
        if (m + NGW < T) { e4n = *(const int4*)(TOPE + (size_t)(m + NGW) * 4); r4n = *(const int4*)(RANK + (size_t)(m + NGW) * 4); w4n = *(const f32x4*)(TOPW + (size_t)(m + NGW) * 4); }
        const v4u* y0 = (const v4u*)(Y + ((size_t)ts[e4.x] * 256 + r4.x) * D) + F.lane; const v4u* y1 = (const v4u*)(Y + ((size_t)ts[e4.y] * 256 + r4.y) * D) + F.lane;
        const v4u* y2 = (const v4u*)(Y + ((size_t)ts[e4.z] * 256 + r4.z) * D) + F.lane; const v4u* y3 = (const v4u*)(Y + ((size_t)ts[e4.w] * 256 + r4.w) * D) + F.lane;
        const v4u* xr = (const v4u*)(X1B + (size_t)m * D) + F.lane;
        v4u ya[4], yb[4], yc[4], yd[4], xv[4];
#pragma unroll
        for (int j = 0; j < 4; ++j) { ya[j] = y0[64 * j]; yb[j] = y1[64 * j]; yc[j] = y2[64 * j]; yd[j] = y3[64 * j]; xv[j] = xr[64 * j]; }
        float acc[4][8]; float s = 0.f;
#pragma unroll
        for (int j = 0; j < 4; ++j) { const LAS float* gp = pg2 + b * 2048 + 512 * j + 8 * F.lane; const f32x4 g0 = *(const LAS f32x4*)gp, g1 = *(const LAS f32x4*)(gp + 4);
            const float gg[8] = {g0.x, g0.y, g0.z, g0.w, g1.x, g1.y, g1.z, g1.w};
            const unsigned aw[4] = {ya[j].x, ya[j].y, ya[j].z, ya[j].w}, bw[4] = {yb[j].x, yb[j].y, yb[j].z, yb[j].w}, cw[4] = {yc[j].x, yc[j].y, yc[j].z, yc[j].w}, dw[4] = {yd[j].x, yd[j].y, yd[j].z, yd[j].w}, xw[4] = {xv[j].x, xv[j].y, xv[j].z, xv[j].w};
#pragma unroll
            for (int q = 0; q < 4; ++q) {
                const float m0 = (w4.x * bflo(aw[q]) + w4.y * bflo(bw[q])) + (w4.z * bflo(cw[q]) + w4.w * bflo(dw[q]));
                const float m1 = (w4.x * bfhi(aw[q]) + w4.y * bfhi(bw[q])) + (w4.z * bfhi(cw[q]) + w4.w * bfhi(dw[q]));
                acc[j][2 * q] = bflo(xw[q]) * ALPHA + gg[2 * q] * m0; acc[j][2 * q + 1] = bfhi(xw[q]) * ALPHA + gg[2 * q + 1] * m1;
                s += acc[j][2 * q] + acc[j][2 * q + 1]; } }
        const float mean = wave_sum(s) * (1.f / D); float s2 = 0.f;
#pragma unroll
        for (int j = 0; j < 4; ++j)
#pragma unroll
            for (int i = 0; i < 8; ++i) { acc[j][i] -= mean; s2 += acc[j][i] * acc[j][i]; }
        const float rstd = 1.f / sqrtf(wave_sum(s2) * (1.f / D) + LN_EPS);
        float* orow = F.out + (size_t)m * D + 8 * F.lane;
#pragma unroll
        for (int j = 0; j < 4; ++j) { const LAS float* lgp = plg + 512 * j + 8 * F.lane; const LAS float* lbp = plb + 512 * j + 8 * F.lane;
            const f32x4 lg0 = *(const LAS f32x4*)lgp, lg1 = *(const LAS f32x4*)(lgp + 4), lb0 = *(const LAS f32x4*)lbp, lb1 = *(const LAS f32x4*)(lbp + 4);
            *(f32x4*)(orow + 512 * j) = (f32x4){acc[j][0], acc[j][1], acc[j][2], acc[j][3]} * rstd * lg0 + lb0;
            *(f32x4*)(orow + 512 * j + 4) = (f32x4){acc[j][4], acc[j][5], acc[j][6], acc[j][7]} * rstd * lg1 + lb1; }
    }
}

__device__ __forceinline__ int opaque(int x) { asm volatile("" : "+v"(x)); return x; }
#define PHASE_FRAME(P) Frame P = F; P.lane = opaque(F.lane); P.tid = opaque(F.tid);
struct Args { const float* in[24]; float* out; unsigned char* ws; int ph_lo, ph_hi, li, pad; };
__global__ void __launch_bounds__(NWAVES * 64, 2) hymba_fwd(Args args) {
    extern __shared__ __attribute__((aligned(16))) unsigned char lds[];
    Frame F;
    F.lds = (LAS unsigned char*)lds;
    F.MISC = (volatile LAS unsigned*)(F.lds + MISC_OFF);
    F.tid = threadIdx.x; F.lane = F.tid & 63; F.wave = __builtin_amdgcn_readfirstlane(F.tid >> 6);
    F.G = gridDim.x; { const int bx = blockIdx.x; F.vcu = (F.G % 8 == 0) ? (bx % 8) * (F.G / 8) + bx / 8 : bx; }
    F.ws = args.ws; F.ctl = (unsigned*)(args.ws + WS_CTL); F.out = args.out;
#pragma unroll
    for (int i = 0; i < 24; ++i) F.in[i] = args.in[i];
    for (int u = F.tid; u < (LDS_BYTES - LDSCTL_OFF) / 4; u += NWAVES * 64) ((LAS unsigned*)(F.lds + LDSCTL_OFF))[u] = 0u;
    __syncthreads();
    const int lo = args.ph_lo, hi = args.ph_hi;
    XcdBarrier bar; bar.bar = F.ctl + CW_BAR + args.li * XCD_BAR_WORDS; bar.x = 0; bar.st = nullptr;
    if (hi - lo > 1) bar = xcd_barrier_post(F.ctl + CW_BAR + args.li * XCD_BAR_WORDS, F.MISC + 8);
#ifndef P9_LAG
#define P9_LAG 3
#endif
#ifndef PHASE_MASK
#define PHASE_MASK 0x7ff
#endif
#define IN(k) ((((PHASE_MASK) >> (k)) & 1) && lo <= (k) && (k) < hi)
#define SEAM(k) do { if (IN(k) && IN((k) + 1)) xcd_barrier(bar); } while (0)
#ifndef PROBE_DUP
#define PROBE_DUP 0
#endif
#define REPS(k) for (int rep_ = 0; rep_ < (((PROBE_DUP) >> (k)) & 1) + 1; ++rep_)
#define REPBAR() do { if (rep_) xcd_barrier(bar); } while (0)

        if (IN(0)) {
        PHASE_FRAME(P) constexpr int NP0 = 64; const int nb0 = F.G >= 2 * NP0 ? NP0 : F.G;
        if ((int)blockIdx.x < nb0) { p0_mod(P, (int)blockIdx.x, nb0); p0_poolw(P, (int)blockIdx.x, nb0); }
        p0_convert(P, CW_Q0);
        if (PROBE_DUP & 1) { xcd_barrier(bar); if ((int)blockIdx.x < nb0) { p0_mod(P, (int)blockIdx.x, nb0); p0_poolw(P, (int)blockIdx.x, nb0); } p0_convert(P, CW_Q0 + 64); } } SEAM(0);
    if (IN(1)) REPS(1) { REPBAR(); PHASE_FRAME(P) p1_modulate(P); } SEAM(1);
    if (IN(2)) REPS(2) { REPBAR();
        pg8::Gemm g{(const bf16*)(F.ws + WS_H), (const bf16*)(F.ws + WS_WIN), D, 0, nullptr}; pg8::DenseOrder S; S.init(T, NPROJ, F.G, (int)blockIdx.x);
        pg8::EpiBf16 E{(bf16*)(F.ws + WS_PROJ), NPROJ, nullptr, 0, 1.0f / W8_SCALE, false};
        pg8::gemm_phase<pg8::EpiBf16, pg8::DenseOrder, false, true>(F.lds, g, S, E);
    } SEAM(2);
    if (IN(3)) REPS(3) { REPBAR(); PHASE_FRAME(P) p3_pool_filter(P); if (PROBE_SUB & 4) p3_pool_filter(P); p3_gla_prep(P); if (PROBE_SUB & 8) p3_gla_prep(P); } SEAM(3);
    if (IN(4)) REPS(4) { REPBAR(); PHASE_FRAME(P) p4_scan(P); } SEAM(4);
    if (IN(5)) REPS(5) { REPBAR(); PHASE_FRAME(P) p5_gla_out(P); } SEAM(5);
    if (IN(6)) REPS(6) { REPBAR();
        pg8::Gemm g{(const bf16*)(F.ws + WS_MIX), (const bf16*)(F.ws + WS_WOUT), D, 0, nullptr}; pg8::DenseOrder S; S.init(T, D, F.G, (int)blockIdx.x);
        pg8::EpiG1 E{(bf16*)(F.ws + WS_Z), (const float*)(F.ws + WS_MOD)};
        pg8::gemm_phase<pg8::EpiG1, pg8::DenseOrder, false, false>(F.lds, g, S, E);
    } SEAM(6);
    if (IN(7)) { PHASE_FRAME(P) p7_ln_router(P);
        if (PROBE_SUB & 16) { xcd_barrier(bar); if (blockIdx.x == 0 && F.tid < NE) __hip_atomic_store(F.ctl + CW_CNT + 64 * F.tid, 0u, RLX_AGENT); xcd_barrier(bar); p7_ln_router(P); } } SEAM(7);
    if (IN(8)) REPS(8) { REPBAR();
        build_ts(F);
        pg8::Gemm g{(const bf16*)(F.ws + WS_H), (const bf16*)(F.ws + WS_WGU), D, (size_t)2 * D * D, (const int*)(F.ws + WS_STOK)};
        const int bx = (int)blockIdx.x; const int grp = bx >> 6; const bool conv = (F.G == 256) && (((bx >> 3) & 7) == 0) && grp < NCONV8;
        const int widx = (F.G == 256) ? bx - 8 * (grp + 1 < NCONV8 ? grp + 1 : NCONV8) : bx, nwork = (F.G == 256) ? 256 - 8 * NCONV8 : F.G;
        if (!conv) {
        pg8::GroupOrder S; S.init((const LAS int*)(F.lds + TS_OFF), 16, nwork, widx);
        pg8::EpiSwiglu E{(unsigned char*)(F.ws + WS_ACT), F.in[17], F.in[19]};
        pg8::gemm_phase<pg8::EpiSwiglu, pg8::GroupOrder, true, true>(F.lds, g, S, E);
        }
        expert_queue(F, CW_Q0 + 128 + 64 * rep_, 2, 3);
    } SEAM(8);
    if (IN(9)) REPS(9) { REPBAR();
        build_ts(F);
        pg8::Gemm g{(const bf16*)(F.ws + WS_ACT), (const bf16*)(F.ws + WS_WDN), D, (size_t)D * D, nullptr};
        pg8::GroupOrder S; S.init((const LAS int*)(F.lds + TS_OFF), 8, F.G, (int)blockIdx.x, 0);
        pg8::EpiBf16 E{(bf16*)(F.ws + WS_Y), D, F.in[21], D, 1.0f / (W8_SCALE * ACT8_SCALE), false};
        { const int rlast = S.total - ((S.total - 1) / F.G) * F.G;
          if (rlast < F.G && (int)blockIdx.x >= rlast) for (int i_ = 0; i_ < P9_LAG; ++i_) __builtin_amdgcn_s_sleep(127); }
        pg8::gemm_phase<pg8::EpiBf16, pg8::GroupOrder, false, true>(F.lds, g, S, E);
    } SEAM(9);
    if (IN(10)) REPS(10) { REPBAR(); PHASE_FRAME(P) p10_final(P); }
#undef IN
#undef SEAM
}

extern "C" void kernel_launch(void* const* d_in, const int* in_sizes, int n_in, void* d_out, int out_size, void* d_ws, size_t ws_size, hipStream_t stream) {
    static int grid = 0;
    if (grid == 0) {
        if (n_in != 24 || in_sizes[0] != T * D || out_size != T * D || ws_size < WS_END) { fprintf(stderr, "kernel_launch: unexpected shapes / workspace (n_in %d, ws %zu); nothing launched\n", n_in, ws_size); grid = -1; return; }
        int dev = 0, cus = 0;
        if (hipGetDevice(&dev) != hipSuccess || hipDeviceGetAttribute(&cus, hipDeviceAttributeMultiprocessorCount, dev) != hipSuccess) { grid = -1; return; }
        if (hipFuncSetAttribute((const void*)hymba_fwd, hipFuncAttributeMaxDynamicSharedMemorySize, LDS_BYTES) != hipSuccess) { fprintf(stderr, "kernel_launch: hipFuncSetAttribute failed\n"); grid = -1; return; }
        int per_cu = 0;
        if (hipOccupancyMaxActiveBlocksPerMultiprocessor(&per_cu, (const void*)hymba_fwd, NWAVES * 64, LDS_BYTES) != hipSuccess || per_cu < 1) fprintf(stderr, "kernel_launch: note: occupancy query reports %d\n", per_cu);
        (void)hipGetLastError();
        grid = cus;
    }
    if (grid < 0) return;
    if (hipMemsetAsync((char*)d_ws + WS_CTL, 0, ZERO_BYTES, stream) != hipSuccess) return;
    Args a{};
    for (int i = 0; i < 24; ++i) a.in[i] = (const float*)d_in[i];
    a.out = (float*)d_out; a.ws = (unsigned char*)d_ws; a.pad = 0;
    constexpr int NL = MK_N_LAUNCHES;
    for (int li = 0; li < NL; ++li) {
        a.ph_lo = (NL == 1) ? 0 : li; a.ph_hi = (NL == 1) ? NPH : li + 1; a.li = 0;
        hipLaunchKernelGGL(hymba_fwd, dim3(grid), dim3(NWAVES * 64), LDS_BYTES, stream, a);
        const hipError_t le = hipPeekAtLastError();
        if (le != hipSuccess) { fprintf(stderr, "kernel_launch: launch %d failed: %s\n", li, hipGetErrorName(le)); break; }
    }
}
```
